# Optimizing an MI355X kernel written in HIP

```python
import math
import jax, jax.numpy as jnp
from jax import lax
import numpy as np

D_MODEL = 2048
BATCH = 2
SEQ = 4096
DEPTH = 1

D_MIX = D_MODEL
HEAD_DIM = 128
ATTN_WIDTH = D_MIX // 2
ATTN_HEADS = ATTN_WIDTH // HEAD_DIM
SSM_WIDTH = D_MIX - ATTN_WIDTH
SSM_GROUP = 16
SSM_GROUPS = SSM_WIDTH // SSM_GROUP
SSM_STATE = 64
DILATED_PATTERNS = ((128, 1), (512, 4), (2048, 16))
BLK = 128
D_FF = 4 * D_MODEL
PLE_DIM = 256
RMS_EPS = 1e-6
NEG_INF = -1e30

kernel_name = "hybrid_dilated_attn_s5_block"


def _rmsnorm(x, g):
    xf = x.astype(jnp.float32)
    y = xf * lax.rsqrt(jnp.mean(xf * xf, axis=-1, keepdims=True) + RMS_EPS)
    return (y * g.astype(jnp.float32)).astype(x.dtype)


def _dilated_branch(q, k, v, window, dilation):
    B, S, H, E = q.shape
    M = S // dilation
    n_keys = window // dilation
    nb = -(-M // BLK)
    Mp = nb * BLK

    def blocks(t):
        t = t.reshape(B, M, dilation, H, E)
        t = jnp.pad(t, ((0, 0), (0, Mp - M), (0, 0), (0, 0), (0, 0)))
        return t.reshape(B, nb, BLK, dilation, H, E)

    def with_prev(t):
        prev = jnp.pad(t[:, :-1], ((0, 0), (1, 0), (0, 0), (0, 0), (0, 0), (0, 0)))
        return jnp.concatenate([prev, t], axis=2)

    qb = blocks(q)
    kk = with_prev(blocks(k))
    vv = with_prev(blocks(v))

    scale = 1.0 / math.sqrt(E)
    s = jnp.einsum('bnqrhe,bnkrhe->bnrhqk', qb, kk,
                   preferred_element_type=jnp.float32) * scale
    i = jnp.arange(BLK)
    j = jnp.arange(2 * BLK)
    blk = jnp.arange(nb)
    dist = BLK + i[:, None] - j[None, :]
    kpos = (blk[:, None] - 1) * BLK + j[None, :]
    mask = ((dist >= 0) & (dist <= n_keys))[None] & (kpos >= 0)[:, None, :]
    s = jnp.where(mask[None, :, None, None], s, NEG_INF)
    lse = jax.nn.logsumexp(s, axis=-1)
    prob = jnp.exp(s - lse[..., None])
    o = jnp.einsum('bnrhqk,bnkrhe->bnqrhe', prob, vv.astype(jnp.float32))
    o = o.reshape(B, Mp, dilation, H, E)[:, :M].reshape(B, S, H, E)
    lse = lse.transpose(0, 1, 4, 2, 3).reshape(B, Mp, dilation, H)[:, :M].reshape(B, S, H)
    return o, lse


def _dilated_attention(q, k, v):
    outs, lses = [], []
    for window, dilation in DILATED_PATTERNS:
        o, l = _dilated_branch(q, k, v, window, dilation)
        outs.append(o)
        lses.append(l)
    w = jax.nn.softmax(jnp.stack(lses, axis=0), axis=0)
    o = jnp.sum(w[..., None] * jnp.stack(outs, axis=0), axis=0)
    B, S, H, E = q.shape
    return o.reshape(B, S, H * E).astype(q.dtype)


def _ssm_combine(e1, e2):
    a1r, a1i, b1r, b1i = e1
    a2r, a2i, b2r, b2i = e2
    ar = a1r * a2r - a1i * a2i
    ai = a1r * a2i + a1i * a2r
    br = a2r * b1r - a2i * b1i + b2r
    bi = a2r * b1i + a2i * b1r + b2i
    return (ar, ai, br, bi)


def _s5(u, lam_re, lam_im, log_dt, b_re, b_im, c_re, c_im, d_skip, w_glu, b_glu):
    B, S, _ = u.shape
    uf = u.astype(jnp.float32).reshape(B, S, SSM_GROUPS, SSM_GROUP)
    lr0 = lam_re.astype(jnp.float32)
    li0 = lam_im.astype(jnp.float32)
    dt = jnp.exp(log_dt.astype(jnp.float32))[:, None]
    mag = jnp.exp(lr0 * dt)
    abar_r = mag * jnp.cos(li0 * dt)
    abar_i = mag * jnp.sin(li0 * dt)
    num_r = abar_r - 1.0
    num_i = abar_i
    den = lr0 * lr0 + li0 * li0
    coef_r = ((num_r * lr0 + num_i * li0) / den)[..., None]
    coef_i = ((num_i * lr0 - num_r * li0) / den)[..., None]
    br = b_re.astype(jnp.float32)
    bi = b_im.astype(jnp.float32)
    bbar_r = coef_r * br - coef_i * bi
    bbar_i = coef_r * bi + coef_i * br
    bu_r = jnp.einsum('bsgc,gpc->bsgp', uf, bbar_r)
    bu_i = jnp.einsum('bsgc,gpc->bsgp', uf, bbar_i)
    a_r = jnp.broadcast_to(abar_r[None, None], (1, S, SSM_GROUPS, SSM_STATE))
    a_i = jnp.broadcast_to(abar_i[None, None], (1, S, SSM_GROUPS, SSM_STATE))
    _, _, st_r, st_i = lax.associative_scan(_ssm_combine, (a_r, a_i, bu_r, bu_i), axis=1)
    y = (jnp.einsum('gcp,bsgp->bsgc', c_re.astype(jnp.float32), st_r)
         - jnp.einsum('gcp,bsgp->bsgc', c_im.astype(jnp.float32), st_i))
    y = y.reshape(B, S, SSM_WIDTH) + d_skip.astype(jnp.float32) * u.astype(jnp.float32)
    y = jax.nn.gelu(y).astype(u.dtype)
    gate = jax.nn.sigmoid(y @ w_glu + b_glu)
    return y * gate


def setup_inputs(seed: int = 0) -> dict:
    key = jax.random.key(seed)
    ks = jax.random.split(key, 32)
    f32 = jnp.float32
    L = DEPTH

    def nrm(k, shape, scale):
        return jax.random.normal(k, shape, f32) * scale

    def gain(k, shape):
        return 1.0 + 0.02 * jax.random.normal(k, shape, f32)

    G, P, C = SSM_GROUPS, SSM_STATE, SSM_GROUP
    n_idx = jnp.arange(P, dtype=f32)
    return {
        "x": nrm(ks[0], (BATCH, SEQ, D_MODEL), 1.0),
        "p": nrm(ks[1], (DEPTH, BATCH, SEQ, PLE_DIM), 1.0),
        "mix_norm_pre": gain(ks[2], (L, D_MODEL)),
        "w_in": nrm(ks[3], (L, D_MODEL, 3 * ATTN_WIDTH + SSM_WIDTH), D_MODEL ** -0.5),
        "lam_re": -0.5 + 0.01 * jax.random.normal(ks[4], (L, G, P), f32),
        "lam_im": math.pi * n_idx + 0.01 * jax.random.normal(ks[5], (L, G, P), f32),
        "log_dt": jax.random.uniform(ks[6], (L, G), f32, math.log(1e-3), math.log(1e-1)),
        "ssm_b_re": nrm(ks[7], (L, G, P, C), (2 * C) ** -0.5),
        "ssm_b_im": nrm(ks[8], (L, G, P, C), (2 * C) ** -0.5),
        "ssm_c_re": nrm(ks[9], (L, G, C, P), (2 * P) ** -0.5),
        "ssm_c_im": nrm(ks[10], (L, G, C, P), (2 * P) ** -0.5),
        "ssm_d": nrm(ks[11], (L, SSM_WIDTH), 1.0),
        "w_glu": nrm(ks[12], (L, SSM_WIDTH, SSM_WIDTH), SSM_WIDTH ** -0.5),
        "b_glu": nrm(ks[13], (L, SSM_WIDTH), 0.01),
        "attn_out_norm": gain(ks[14], (L, ATTN_WIDTH)),
        "ssm_out_norm": gain(ks[15], (L, SSM_WIDTH)),
        "w_out": nrm(ks[16], (L, D_MIX, D_MODEL), D_MIX ** -0.5),
        "mix_norm_post": gain(ks[17], (L, D_MODEL)),
        "mlp_norm_pre": gain(ks[18], (L, D_MODEL)),
        "w_up": nrm(ks[19], (L, D_MODEL, D_FF), D_MODEL ** -0.5),
        "w_down": nrm(ks[20], (L, D_FF, D_MODEL), D_FF ** -0.5),
        "mlp_norm_post": gain(ks[21], (L, D_MODEL)),
        "ple_norm_pre": gain(ks[22], (L, D_MODEL)),
        "w_ple_gate": nrm(ks[23], (L, D_MODEL, D_MODEL), D_MODEL ** -0.5),
        "w_ple_proj": nrm(ks[24], (L, PLE_DIM, D_MODEL), PLE_DIM ** -0.5),
        "ple_norm_post": gain(ks[25], (L, D_MODEL)),
    }


def reference(x, p, mix_norm_pre, w_in, lam_re, lam_im, log_dt, ssm_b_re, ssm_b_im,
              ssm_c_re, ssm_c_im, ssm_d, w_glu, b_glu, attn_out_norm, ssm_out_norm,
              w_out, mix_norm_post, mlp_norm_pre, w_up, w_down, mlp_norm_post,
              ple_norm_pre, w_ple_gate, w_ple_proj, ple_norm_post):
    B, S, _ = x.shape
    h = x
    for i in range(DEPTH):
        hn = _rmsnorm(h, mix_norm_pre[i])
        proj = hn @ w_in[i]
        q = proj[..., :ATTN_WIDTH].reshape(B, S, ATTN_HEADS, HEAD_DIM)
        k = proj[..., ATTN_WIDTH:2 * ATTN_WIDTH].reshape(B, S, ATTN_HEADS, HEAD_DIM)
        v = proj[..., 2 * ATTN_WIDTH:3 * ATTN_WIDTH].reshape(B, S, ATTN_HEADS, HEAD_DIM)
        u = proj[..., 3 * ATTN_WIDTH:]
        attn = _dilated_attention(q, k, v)
        ssm = _s5(u, lam_re[i], lam_im[i], log_dt[i], ssm_b_re[i], ssm_b_im[i],
                  ssm_c_re[i], ssm_c_im[i], ssm_d[i], w_glu[i], b_glu[i])
        mixed = jnp.concatenate([_rmsnorm(attn, attn_out_norm[i]),
                                 _rmsnorm(ssm, ssm_out_norm[i])], axis=-1)
        h = h + _rmsnorm(mixed @ w_out[i], mix_norm_post[i])
        hn = _rmsnorm(h, mlp_norm_pre[i])
        ff = jnp.square(jax.nn.relu(hn @ w_up[i])) @ w_down[i]
        h = h + _rmsnorm(ff, mlp_norm_post[i])
        gate = jax.nn.sigmoid(_rmsnorm(h, ple_norm_pre[i]) @ w_ple_gate[i])
        e = p[i] @ w_ple_proj[i]
        h = h + _rmsnorm(gate * e, ple_norm_post[i])
    return h
```

```cpp
#include <hip/hip_runtime.h>
#include <hip/hip_cooperative_groups.h>
#include <cstdio>
#include <cstdint>
namespace cg = cooperative_groups;
namespace pg8 {
#define PG8_LAS __attribute__((address_space(3)))
typedef unsigned short bf16_t;
typedef short bf16x8 __attribute__((ext_vector_type(8)));
typedef float f32x4 __attribute__((ext_vector_type(4)));
typedef unsigned u32x4 __attribute__((ext_vector_type(4)));
constexpr int BM = 256, BK = 64, HALF = 128, HTB = HALF * BK * 2  , STAGE_BYTES = 8 * HTB, NXCD = 8, WGM = 8;

__host__ __device__ __forceinline__ int lds_byte(int r, int c) { const int st = (r >> 4) * 2 + (c >> 5), rr = r & 15, cc = c & 31, ob = rr * 64 + cc * 2; return st * 1024 + (ob ^ (((ob >> 9) & 1) << 5)); }
__host__ __device__ __forceinline__ void stage_rc(int b, int& R, int& C) { const int st = b / 1024, sb = b % 1024, swz = sb ^ (((sb >> 9) & 1) << 5); R = (st >> 1) * 16 + swz / 64; C = (st & 1) * 32 + (swz % 64) / 2; }
__host__ __device__ __forceinline__ int perm32(int rho) { const int n = rho >> 4, i = rho & 15; return 8 * (i >> 2) + 4 * n + (i & 3); }

struct Unit { int pm, pn; };
struct Gemm { const bf16_t* A; const bf16_t* Bt; int M, N, K, lda, ldb; };

struct StaticOrder {
    int nM, nN, nwg, G, c;
    __host__ __device__ void init(int M, int N, int G_, int c_) { nM = M / BM; nN = N / BM; nwg = nM * nN; G = G_; c = c_; }
    __host__ __device__ bool next(int i, Unit& u) const {
        const long L = (long)i * G + c; if (L >= nwg) return false;
        int wgid = (int)L; { const int q = nwg / NXCD, r = nwg % NXCD, xcd = wgid % NXCD, off = wgid / NXCD; wgid = (xcd < r ? xcd * (q + 1) : r * (q + 1) + (xcd - r) * q) + off; }
        const int nig = WGM * nN, gid = wgid / nig, fm = gid * WGM, gsz = (nM - fm) < WGM ? (nM - fm) : WGM;
        u.pm = fm + ((wgid % nig) % gsz); u.pn = (wgid % nig) / gsz; return true;
    }
    __device__ __forceinline__ void a_ready(const Unit&) const {}
    __device__ __forceinline__ void done(const Unit&) const {}
};

struct GroupOrder {
    int nj, total, G, c;
    __device__ __forceinline__ bool next(int i, Unit& u) const { const int id = i * G + c; if (id >= total) return false; const int g = id / nj; u.pm = g; u.pn = g * nj + (id - g * nj); return true; }
    __device__ __forceinline__ void a_ready(const Unit&) const {}
    __device__ __forceinline__ void done(const Unit&) const {}
};

struct StateOrder { int ng, G, c;
    __device__ __forceinline__ bool next(int i, Unit& u) const { const int g = c + i * G; if (g >= ng) return false; u.pm = g; u.pn = g; return true; }
    __device__ __forceinline__ void a_ready(const Unit&) const {}
    __device__ __forceinline__ void done(const Unit&) const {} };
struct OutOrder { int ng, G, c;
    __device__ __forceinline__ bool next(int i, Unit& u) const { const int g = c + (i >> 1) * G; if (g >= ng) return false; u.pm = g; u.pn = 2 * g + (i & 1); return true; }
    __device__ __forceinline__ void a_ready(const Unit&) const {}
    __device__ __forceinline__ void done(const Unit&) const {} };
__device__ __forceinline__ unsigned f2bf(float f) { unsigned u = __builtin_bit_cast(unsigned, f); return (u + 0x7fffu + ((u >> 16) & 1u)) >> 16; }
__device__ __forceinline__ unsigned pk2(float lo, float hi) { return f2bf(lo) | (f2bf(hi) << 16); }
__device__ __forceinline__ float bflo(unsigned w) { return __builtin_bit_cast(float, w << 16); }
__device__ __forceinline__ float bfhi(unsigned w) { return __builtin_bit_cast(float, w & 0xffff0000u); }
__device__ __forceinline__ u32x4 pack8(const f32x4& v0, const f32x4& v1) { u32x4 w; w.x = pk2(v0[0], v0[1]); w.y = pk2(v0[2], v0[3]); w.z = pk2(v1[0], v1[1]); w.w = pk2(v1[2], v1[3]); return w; }
__device__ __forceinline__ float sigmoidf_(float x) { return 1.0f / (1.0f + __expf(-x)); }
__device__ __forceinline__ float gelu_tanh(float x) { const float z = 0.7978845608028654f * (x + 0.044715f * x * x * x); return x / (1.0f + __expf(-2.0f * z)); }

struct EpiProj {
    static constexpr bool PERM = true, AFTER_DRAIN = false;
    bf16_t* Q; size_t split_stride; bf16_t* UG; float qscale;
    __device__ __forceinline__ void operator()(const f32x4 (&acc)[2][2][4][2], const Unit& u, int wr, int wc, int fr, int fq) const {
        const int row0 = u.pm * BM + wr * 64 + fr; const int t = u.pn >> 2; const int colt = (u.pn & 3) * BM + wc * 32 + 8 * fq;
        const float sc = 1.f + (t == 0 ? 1.f : 0.f) * (qscale - 1.f);
        bf16_t* base = Q + (size_t)(t < 3 ? t : 0) * split_stride;
#pragma unroll
        for (int ai = 0; ai < 2; ++ai)
#pragma unroll
            for (int m = 0; m < 4; ++m) { const int row = row0 + ai * HALF + m * 16;
#pragma unroll
                for (int bj = 0; bj < 2; ++bj) { const f32x4 v0 = acc[ai][bj][m][0] * sc, v1 = acc[ai][bj][m][1] * sc; const u32x4 w = pack8(v0, v1); const int col = colt + bj * HALF;
                    if (t < 3) *(u32x4*)(base + (size_t)row * 1024 + col) = w;
                    else { const int g = col >> 4, c = col & 15, cr = row >> 5, tt = row & 31; *(u32x4*)(UG + ((size_t)(g * 256 + cr)) * 640 + tt * 16 + c) = w; } } }
    }
};
struct EpiE {
    static constexpr bool PERM = false, AFTER_DRAIN = false;
    float* E;
    __device__ __forceinline__ void operator()(const f32x4 (&acc)[2][2][4][2], const Unit& u, int wr, int wc, int fr, int fq) const {
#pragma unroll
        for (int ai = 0; ai < 2; ++ai)
#pragma unroll
            for (int m = 0; m < 4; ++m) { const int r = ai * HALF + wr * 64 + m * 16 + fr;
#pragma unroll
                for (int n = 0; n < 2; ++n) *(f32x4*)(E + ((size_t)(u.pm * 256 + r)) * 128 + wc * 32 + 16 * n + 4 * fq) = acc[ai][0][m][n]; }
    }
};
struct EpiY {
    static constexpr bool PERM = true, AFTER_DRAIN = false;
    const bf16_t* UG; const float* Dskip; bf16_t* YB;
    __device__ __forceinline__ void operator()(const f32x4 (&acc)[2][2][4][2], const Unit& u, int wr, int wc, int fr, int fq) const {
        const int g = u.pm, j = u.pn - 2 * g;
#pragma unroll
        for (int bj = 0; bj < 2; ++bj) { const int cgc = j * 256 + bj * HALF + wc * 32 + 8 * fq; const int t = cgc >> 4, c = cgc & 15, ch = g * 16 + c;
            const f32x4 d0 = *(const f32x4*)(Dskip + ch), d1 = *(const f32x4*)(Dskip + ch + 4);
#pragma unroll
            for (int ai = 0; ai < 2; ++ai)
#pragma unroll
                for (int m = 0; m < 4; ++m) { const int r = ai * HALF + wr * 64 + m * 16 + fr;
                    const u32x4 uw = *(const u32x4*)(UG + ((size_t)(g * 256 + r)) * 640 + cgc);
                    f32x4 v0 = acc[ai][bj][m][0], v1 = acc[ai][bj][m][1];
                    v0[0] += d0[0] * bflo(uw.x); v0[1] += d0[1] * bfhi(uw.x); v0[2] += d0[2] * bflo(uw.y); v0[3] += d0[3] * bfhi(uw.y);
                    v1[0] += d1[0] * bflo(uw.z); v1[1] += d1[1] * bfhi(uw.z); v1[2] += d1[2] * bflo(uw.w); v1[3] += d1[3] * bfhi(uw.w);
#pragma unroll
                    for (int e = 0; e < 4; ++e) { v0[e] = gelu_tanh(v0[e]); v1[e] = gelu_tanh(v1[e]); }
                    *(u32x4*)(YB + ((size_t)(r * 32 + t)) * 1024 + ch) = pack8(v0, v1); } }
    }
};
struct EpiGLU {
    static constexpr bool PERM = true, AFTER_DRAIN = false;
    const bf16_t* YB; const float* bias; bf16_t* O;
    __device__ __forceinline__ void operator()(const f32x4 (&acc)[2][2][4][2], const Unit& u, int wr, int wc, int fr, int fq) const {
        const int row0 = u.pm * BM + wr * 64 + fr;
#pragma unroll
        for (int bj = 0; bj < 2; ++bj) { const int col = u.pn * BM + bj * HALF + wc * 32 + 8 * fq;
            const f32x4 b0 = *(const f32x4*)(bias + col), b1 = *(const f32x4*)(bias + col + 4);
#pragma unroll
            for (int ai = 0; ai < 2; ++ai)
#pragma unroll
                for (int m = 0; m < 4; ++m) { const size_t off = (size_t)(row0 + ai * HALF + m * 16) * 1024 + col;
                    const u32x4 yw = *(const u32x4*)(YB + off);
                    f32x4 v0 = acc[ai][bj][m][0] + b0, v1 = acc[ai][bj][m][1] + b1;
                    v0[0] = bflo(yw.x) * sigmoidf_(v0[0]); v0[1] = bfhi(yw.x) * sigmoidf_(v0[1]); v0[2] = bflo(yw.y) * sigmoidf_(v0[2]); v0[3] = bfhi(yw.y) * sigmoidf_(v0[3]);
                    v1[0] = bflo(yw.z) * sigmoidf_(v1[0]); v1[1] = bfhi(yw.z) * sigmoidf_(v1[1]); v1[2] = bflo(yw.w) * sigmoidf_(v1[2]); v1[3] = bfhi(yw.w) * sigmoidf_(v1[3]);
                    *(u32x4*)(O + off) = pack8(v0, v1); } }
    }
};
struct EpiF32 {
    static constexpr bool PERM = false, AFTER_DRAIN = false;
    float* O; int ldc;
    __device__ __forceinline__ void operator()(const f32x4 (&acc)[2][2][4][2], const Unit& u, int wr, int wc, int fr, int fq) const {
        const int row0 = u.pm * BM + wr * 64 + fr, col0 = u.pn * BM + wc * 32 + 4 * fq;
#pragma unroll
        for (int ai = 0; ai < 2; ++ai)
#pragma unroll
            for (int m = 0; m < 4; ++m) { float* rowp = O + (size_t)(row0 + ai * HALF + m * 16) * ldc + col0;
#pragma unroll
                for (int bj = 0; bj < 2; ++bj)
#pragma unroll
                    for (int n = 0; n < 2; ++n) *(f32x4*)(rowp + bj * HALF + n * 16) = acc[ai][bj][m][n]; }
    }
};
struct EpiBf16Plain {
    static constexpr bool PERM = true, AFTER_DRAIN = false;
    bf16_t* O; int ldc;
    __device__ __forceinline__ void operator()(const f32x4 (&acc)[2][2][4][2], const Unit& u, int wr, int wc, int fr, int fq) const {
        const int row0 = u.pm * BM + wr * 64 + fr, col0 = u.pn * BM + wc * 32 + 8 * fq;
#pragma unroll
        for (int ai = 0; ai < 2; ++ai)
#pragma unroll
            for (int m = 0; m < 4; ++m) { bf16_t* rowp = O + (size_t)(row0 + ai * HALF + m * 16) * ldc + col0;
#pragma unroll
                for (int bj = 0; bj < 2; ++bj) *(u32x4*)(rowp + bj * HALF) = pack8(acc[ai][bj][m][0], acc[ai][bj][m][1]); }
    }
};
struct EpiGateBf {
    static constexpr bool PERM = true, AFTER_DRAIN = false;
    bf16_t* GE; int ldc;
    __device__ __forceinline__ void operator()(const f32x4 (&acc)[2][2][4][2], const Unit& u, int wr, int wc, int fr, int fq) const {
        const int row0 = u.pm * BM + wr * 64 + fr, col0 = u.pn * BM + wc * 32 + 8 * fq;
#pragma unroll
        for (int ai = 0; ai < 2; ++ai)
#pragma unroll
            for (int m = 0; m < 4; ++m) { bf16_t* rowp = GE + (size_t)(row0 + ai * HALF + m * 16) * ldc + col0;
#pragma unroll
                for (int bj = 0; bj < 2; ++bj) { const u32x4 ew = *(const u32x4*)(rowp + bj * HALF); f32x4 v0 = acc[ai][bj][m][0], v1 = acc[ai][bj][m][1];
                    v0[0] = bflo(ew.x) * sigmoidf_(v0[0]); v0[1] = bfhi(ew.x) * sigmoidf_(v0[1]); v0[2] = bflo(ew.y) * sigmoidf_(v0[2]); v0[3] = bfhi(ew.y) * sigmoidf_(v0[3]);
                    v1[0] = bflo(ew.z) * sigmoidf_(v1[0]); v1[1] = bfhi(ew.z) * sigmoidf_(v1[1]); v1[2] = bflo(ew.w) * sigmoidf_(v1[2]); v1[3] = bfhi(ew.w) * sigmoidf_(v1[3]);
                    *(u32x4*)(rowp + bj * HALF) = pack8(v0, v1); } }
    }
};
struct EpiRelu2 {
    static constexpr bool PERM = true, AFTER_DRAIN = false;
    bf16_t* O; int ldc;
    __device__ __forceinline__ void operator()(const f32x4 (&acc)[2][2][4][2], const Unit& u, int wr, int wc, int fr, int fq) const {
        const int row0 = u.pm * BM + wr * 64 + fr, col0 = u.pn * BM + wc * 32 + 8 * fq;
#pragma unroll
        for (int ai = 0; ai < 2; ++ai)
#pragma unroll
            for (int m = 0; m < 4; ++m) { bf16_t* rowp = O + (size_t)(row0 + ai * HALF + m * 16) * ldc + col0;
#pragma unroll
                for (int bj = 0; bj < 2; ++bj) { f32x4 v0 = acc[ai][bj][m][0], v1 = acc[ai][bj][m][1];
#pragma unroll
                    for (int e = 0; e < 4; ++e) { const float a = fmaxf(v0[e], 0.f), b = fmaxf(v1[e], 0.f); v0[e] = a * a; v1[e] = b * b; }
                    *(u32x4*)(rowp + bj * HALF) = pack8(v0, v1); } }
    }
};
struct EpiGate {
    static constexpr bool PERM = false, AFTER_DRAIN = false;
    float* GE; int ldc;
    __device__ __forceinline__ void operator()(const f32x4 (&acc)[2][2][4][2], const Unit& u, int wr, int wc, int fr, int fq) const {
        const int row0 = u.pm * BM + wr * 64 + fr, col0 = u.pn * BM + wc * 32 + 4 * fq;
#pragma unroll
        for (int ai = 0; ai < 2; ++ai)
#pragma unroll
            for (int m = 0; m < 4; ++m) { float* rowp = GE + (size_t)(row0 + ai * HALF + m * 16) * ldc + col0;
#pragma unroll
                for (int bj = 0; bj < 2; ++bj)
#pragma unroll
                    for (int n = 0; n < 2; ++n) { const f32x4 e = *(const f32x4*)(rowp + bj * HALF + n * 16); const f32x4 a = acc[ai][bj][m][n]; f32x4 o;
#pragma unroll
                        for (int q = 0; q < 4; ++q) o[q] = e[q] * sigmoidf_(a[q]);
                        *(f32x4*)(rowp + bj * HALF + n * 16) = o; } }
    }
};

template <class Epi, class Sched, bool ALIGN_EPI = false, bool SP2 = false>
__device__ __forceinline__ void gemm_phase(PG8_LAS unsigned char* lds, const Gemm g, const Sched& S, const Epi& E) {
    const int tid = threadIdx.x, wid = __builtin_amdgcn_readfirstlane(tid >> 6), lane = tid & 63, wr = wid >> 2, wc = wid & 3, fr = lane & 15, fq = lane >> 4;
    const int K = g.K, nt = K / BK;
    unsigned voffA[2], voffB[2];
#pragma unroll
    for (int i = 0; i < 2; ++i) { int R, C; stage_rc(tid * 16 + i * 8192, R, C); const int Rb = Epi::PERM ? ((R & ~31) + perm32(R & 31)) : R;
        voffA[i] = (unsigned)(R * g.lda + C) * 2u; voffB[i] = (unsigned)(Rb * g.ldb + C) * 2u; }
    const size_t kstep = (size_t)(BK * 2);
    const size_t hstepA = (size_t)HALF * g.lda * 2, hstepB = (size_t)HALF * g.ldb * 2;
    const size_t tstepA = 2 * hstepA, tstepB = 2 * hstepB;
    const unsigned ldsw = (unsigned)wid * 1024u;
    const int aoff = lds_byte(wr * 64 + fr, fq * 8), boff = lds_byte(wc * 32 + fr, fq * 8);
#define PG8_SA(b, h) (((b) * 2 + (h)) * HTB)
#define PG8_SB(b, h) ((4 + (b) * 2 + (h)) * HTB)
#define PG8_STAGE(bufoff, gbase, voff) do { _Pragma("unroll") for (int _i = 0; _i < 2; ++_i) \
        __builtin_amdgcn_global_load_lds((const unsigned*)((const char*)(gbase) + (voff)[_i]), (PG8_LAS unsigned*)(lds + (bufoff) + ldsw + _i * 8192), 16, 0, 0); } while (0)
#define PG8_LDA(dst, b, h) do { _Pragma("unroll") for (int m = 0; m < 4; ++m) _Pragma("unroll") for (int k = 0; k < 2; ++k) dst[m][k] = *(const PG8_LAS bf16x8*)(lds + PG8_SA(b, h) + aoff + m * 2048 + k * 1024); } while (0)
#define PG8_LDB(dst, b, h) do { _Pragma("unroll") for (int n = 0; n < 2; ++n) _Pragma("unroll") for (int k = 0; k < 2; ++k) dst[n][k] = *(const PG8_LAS bf16x8*)(lds + PG8_SB(b, h) + boff + n * 2048 + k * 1024); } while (0)
#define PG8_MMA(ai, bj, At, Bt) do { __builtin_amdgcn_s_setprio(1); _Pragma("unroll") for (int m = 0; m < 4; ++m) _Pragma("unroll") for (int n = 0; n < 2; ++n) _Pragma("unroll") for (int k = 0; k < 2; ++k) \
        acc[ai][bj][m][n] = __builtin_amdgcn_mfma_f32_16x16x32_bf16(Bt[n][k], At[m][k], acc[ai][bj][m][n], 0, 0, 0); __builtin_amdgcn_s_setprio(0); } while (0)
#define PG8_WAIT_V(n) asm volatile("s_waitcnt vmcnt(" #n ")" ::: "memory")
#define PG8_WAIT_L(n) asm volatile("s_waitcnt lgkmcnt(" #n ")" ::: "memory")
#define PG8_BAR __builtin_amdgcn_s_barrier()
#define PG8_SCHED __builtin_amdgcn_sched_barrier(0)
    Unit cur, nxt; int ui = 0;
    if (!S.next(0, cur)) return;
    f32x4 acc[2][2][4][2];
#pragma unroll
    for (int a = 0; a < 2; ++a)
#pragma unroll
        for (int b = 0; b < 2; ++b)
#pragma unroll
            for (int m = 0; m < 4; ++m)
#pragma unroll
                for (int n = 0; n < 2; ++n) acc[a][b][m][n] = (f32x4){0.f, 0.f, 0.f, 0.f};
    bf16x8 At[4][2], B0[2][2], B1[2][2];
    const char* cA = (const char*)g.A + (size_t)cur.pm * tstepA; const char* cB = (const char*)g.Bt + (size_t)cur.pn * tstepB;
    S.a_ready(cur);
    if constexpr (SP2) {
        PG8_STAGE(PG8_SB(0, 0), cB, voffB); PG8_STAGE(PG8_SB(0, 1), cB + hstepB, voffB); PG8_STAGE(PG8_SA(0, 0), cA, voffA); PG8_STAGE(PG8_SA(0, 1), cA + hstepA, voffA);
        if (wr == 1) PG8_BAR;
        PG8_WAIT_V(2); PG8_BAR;
        PG8_STAGE(PG8_SB(1, 0), cB + kstep, voffB); PG8_STAGE(PG8_SA(1, 0), cA + kstep, voffA); PG8_STAGE(PG8_SB(1, 1), cB + hstepB + kstep, voffB);
        PG8_WAIT_V(6); PG8_BAR;
    } else {
        PG8_STAGE(PG8_SB(0, 0), cB, voffB); PG8_STAGE(PG8_SA(0, 0), cA, voffA); PG8_STAGE(PG8_SB(0, 1), cB + hstepB, voffB); PG8_STAGE(PG8_SA(0, 1), cA + hstepA, voffA);
        if (wr == 1) PG8_BAR;
        PG8_WAIT_V(4); PG8_BAR;
        PG8_STAGE(PG8_SB(1, 0), cB + kstep, voffB); PG8_STAGE(PG8_SA(1, 0), cA + kstep, voffA); PG8_STAGE(PG8_SB(1, 1), cB + hstepB + kstep, voffB);
        PG8_WAIT_V(6); PG8_BAR;
    }
    for (;;) {
        const bool has_next = S.next(ui + 1, nxt);
        const char* nA = has_next ? (const char*)g.A + (size_t)nxt.pm * tstepA : cA; const char* nB = has_next ? (const char*)g.Bt + (size_t)nxt.pn * tstepB : cB;
        for (int t = 0; t < nt; t += 2) {
            const bool last = (t == nt - 2);
            const char* a1 = cA + (size_t)(t + 1) * kstep;
            const char* a2 = last ? nA : cA + (size_t)(t + 2) * kstep; const char* b2 = last ? nB : cB + (size_t)(t + 2) * kstep;
            const char* a3 = a2 + kstep; const char* b3 = b2 + kstep;
            if (last && has_next) S.a_ready(nxt);
            if constexpr (SP2) {
            PG8_LDB(B0, 0, 0); PG8_LDB(B1, 0, 1); PG8_SCHED; PG8_LDA(At, 0, 0); PG8_STAGE(PG8_SA(1, 1), a1 + hstepA, voffA);
            PG8_WAIT_V(8); PG8_WAIT_L(0); PG8_BAR; PG8_MMA(0, 0, At, B0); PG8_MMA(0, 1, At, B1); PG8_BAR; PG8_SCHED;
            PG8_LDA(At, 0, 1); PG8_STAGE(PG8_SB(0, 0), b2, voffB); PG8_STAGE(PG8_SB(0, 1), b2 + hstepB, voffB); PG8_STAGE(PG8_SA(0, 0), a2, voffA);
            PG8_WAIT_V(8); PG8_WAIT_L(0); PG8_BAR; PG8_MMA(1, 0, At, B0); PG8_MMA(1, 1, At, B1); PG8_BAR; PG8_SCHED;
            PG8_LDB(B0, 1, 0); PG8_LDB(B1, 1, 1); PG8_SCHED; PG8_LDA(At, 1, 0); PG8_STAGE(PG8_SA(0, 1), a2 + hstepA, voffA);
            PG8_WAIT_V(8); PG8_WAIT_L(0); PG8_BAR; PG8_MMA(0, 0, At, B0); PG8_MMA(0, 1, At, B1); PG8_BAR; PG8_SCHED;
            PG8_LDA(At, 1, 1); PG8_STAGE(PG8_SB(1, 0), b3, voffB); PG8_STAGE(PG8_SB(1, 1), b3 + hstepB, voffB); PG8_STAGE(PG8_SA(1, 0), a3, voffA);
            PG8_WAIT_V(8); PG8_WAIT_L(0); PG8_BAR; PG8_MMA(1, 0, At, B0); PG8_MMA(1, 1, At, B1); PG8_BAR; PG8_SCHED;
            } else {
            PG8_LDB(B0, 0, 0); PG8_SCHED; PG8_LDA(At, 0, 0); PG8_STAGE(PG8_SA(1, 1), a1 + hstepA, voffA);
            PG8_WAIT_L(8); PG8_BAR; PG8_WAIT_L(0); PG8_MMA(0, 0, At, B0); PG8_BAR; PG8_SCHED;
            PG8_LDB(B1, 0, 1); PG8_STAGE(PG8_SB(0, 0), b2, voffB);
            PG8_BAR; PG8_WAIT_L(0); PG8_MMA(0, 1, At, B1); PG8_BAR;
            PG8_LDA(At, 0, 1); PG8_STAGE(PG8_SA(0, 0), a2, voffA);
            PG8_BAR; PG8_WAIT_L(0); PG8_MMA(1, 0, At, B0); PG8_BAR; PG8_SCHED;
            PG8_STAGE(PG8_SB(0, 1), b2 + hstepB, voffB);
            PG8_WAIT_V(6); PG8_BAR; PG8_MMA(1, 1, At, B1); PG8_BAR;
            PG8_LDB(B0, 1, 0); PG8_SCHED; PG8_LDA(At, 1, 0); PG8_STAGE(PG8_SA(0, 1), a2 + hstepA, voffA);
            PG8_WAIT_L(8); PG8_BAR; PG8_WAIT_L(0); PG8_MMA(0, 0, At, B0); PG8_BAR; PG8_SCHED;
            PG8_LDB(B1, 1, 1); PG8_STAGE(PG8_SB(1, 0), b3, voffB);
            PG8_BAR; PG8_WAIT_L(0); PG8_MMA(0, 1, At, B1); PG8_BAR;
            PG8_LDA(At, 1, 1); PG8_STAGE(PG8_SA(1, 0), a3, voffA);
            PG8_BAR; PG8_WAIT_L(0); PG8_MMA(1, 0, At, B0); PG8_BAR; PG8_SCHED;
            PG8_STAGE(PG8_SB(1, 1), b3 + hstepB, voffB);
            PG8_WAIT_V(6); PG8_BAR; PG8_MMA(1, 1, At, B1); PG8_BAR;
            }
        }
        if constexpr (ALIGN_EPI) { if (wr == 0) PG8_BAR; }
        if constexpr (!Epi::AFTER_DRAIN) { E(acc, cur, wr, wc, fr, fq); S.done(cur); }
        if (!has_next) break;
#pragma unroll
        for (int a = 0; a < 2; ++a)
#pragma unroll
            for (int b = 0; b < 2; ++b)
#pragma unroll
                for (int m = 0; m < 4; ++m)
#pragma unroll
                    for (int n = 0; n < 2; ++n) acc[a][b][m][n] = (f32x4){0.f, 0.f, 0.f, 0.f};
        cur = nxt; cA = nA; cB = nB; ++ui;
        if constexpr (ALIGN_EPI) { if (wr == 1) PG8_BAR; }
    }
    PG8_WAIT_V(0);
    if constexpr (!ALIGN_EPI) { if (wr == 0) PG8_BAR; }
    PG8_BAR;
    if constexpr (Epi::AFTER_DRAIN) { E.fused(acc, cur, wr, wc, fr, fq, lds, wid, lane); S.done(cur); }
#undef PG8_SA
#undef PG8_SB
#undef PG8_STAGE
#undef PG8_LDA
#undef PG8_LDB
#undef PG8_MMA
#undef PG8_WAIT_V
#undef PG8_WAIT_L
#undef PG8_BAR
#undef PG8_SCHED
}
}

constexpr int NWAVES = 8, NTHREADS = 512;
constexpr int M_TOK = 8192, SEQ = 4096, DM = 2048, NPROJ = 4096, AW = 1024, NH = 8, DFF = 8192, PLE = 256;
constexpr int SG = 64, SP = 64, SC = 16, CHL = 32, UGK = 640;
constexpr float RMS_EPS = 1e-6f;
constexpr float QSCALE = 0.08838834764831845f * 1.4426950408889634f;

constexpr size_t MiB = 1u << 20;
constexpr size_t WS_XN = 1 * MiB;
constexpr size_t WS_WIN = 33 * MiB, WS_WGLU = 49 * MiB, WS_WOUT = 51 * MiB;
constexpr size_t WS_Q = 59 * MiB, WS_K = 75 * MiB, WS_V = 91 * MiB;
constexpr size_t WS_SSMO = WS_K, WS_YB = WS_WIN;
constexpr size_t WS_UG = 107 * MiB, WS_E = 127 * MiB, WS_HST = 135 * MiB, WS_BSB = 151 * MiB;
constexpr size_t WS_OB = 191 * MiB, WS_LSE = 239 * MiB, WS_PW = 240 * MiB, WS_BBAR = 242 * MiB, WS_KT = 243 * MiB;
constexpr size_t WS_MIX = 123 * MiB;
constexpr size_t WS_WUP = 33 * MiB, WS_WDOWN = 65 * MiB, WS_WG = 97 * MiB, WS_WP = 105 * MiB, WS_PB = 106 * MiB;
constexpr size_t WS_HID = 123 * MiB;
constexpr size_t WS_FF = 1 * MiB;
constexpr size_t WS_XN3 = 123 * MiB, WS_GE = 155 * MiB;
constexpr size_t WS_END = 251 * MiB;
constexpr size_t OB_STRIDE = (size_t)M_TOK * AW;

constexpr int LDS_BYTES = 147456;
#define LAS __attribute__((address_space(3)))
typedef unsigned short bf16;
typedef unsigned v4u __attribute__((ext_vector_type(4)));
typedef unsigned v2u __attribute__((ext_vector_type(2)));
typedef float f32x4 __attribute__((ext_vector_type(4)));
typedef float f32x2 __attribute__((ext_vector_type(2)));
typedef float f32x16 __attribute__((ext_vector_type(16)));
typedef short bf16x8 __attribute__((ext_vector_type(8)));
using pg8::f2bf; using pg8::pk2; using pg8::bflo; using pg8::bfhi;
#define LDS_WAIT() asm volatile("s_waitcnt lgkmcnt(0)" ::: "memory")

__device__ __forceinline__ float wave_sum(float v) {
#pragma unroll
    for (int o = 1; o < 64; o <<= 1) v += __shfl_xor(v, o);
    return v;
}
__device__ __forceinline__ void transpose_item(const float* W, int K, int N, bf16* WT, LAS float* scr, int item, int lane) {
    const int nblk = N / 32, kb = item / nblk, nb = item % nblk, k0 = 64 * kb, n0 = 32 * nb;
    { f32x4 t4[8];
#pragma unroll
      for (int i = 0; i < 8; ++i) t4[i] = *(const f32x4*)(W + (size_t)(k0 + 8 * i + (lane >> 3)) * N + n0 + 4 * (lane & 7));
#pragma unroll
      for (int i = 0; i < 8; ++i) { LAS float* d = scr + (8 * i + (lane >> 3)) * 33 + 4 * (lane & 7); d[0] = t4[i].x; d[1] = t4[i].y; d[2] = t4[i].z; d[3] = t4[i].w; } }
    LDS_WAIT();
    const int c = lane & 7;
#pragma unroll
    for (int j = 0; j < 4; ++j) { const int n = (lane >> 3) + 8 * j; const LAS float* s = scr + (8 * c) * 33 + n;
        v4u o; o.x = pk2(s[0 * 33], s[1 * 33]); o.y = pk2(s[2 * 33], s[3 * 33]); o.z = pk2(s[4 * 33], s[5 * 33]); o.w = pk2(s[6 * 33], s[7 * 33]);
        *(v4u*)(WT + (size_t)(n0 + n) * K + k0 + 8 * c) = o; }
    LDS_WAIT();
}
__device__ __forceinline__ void rms_row_to_bf16(const float* xrow, const float* gain, bf16* orow, int lane) {
    const f32x4* xr = (const f32x4*)xrow + lane; const f32x4* gr = (const f32x4*)gain + lane;
    f32x4 v[8]; float s = 0.f;
#pragma unroll
    for (int j = 0; j < 8; ++j) { v[j] = xr[64 * j]; s += (v[j].x * v[j].x + v[j].y * v[j].y) + (v[j].z * v[j].z + v[j].w * v[j].w); }
    const float rs = 1.0f / sqrtf(wave_sum(s) * (1.0f / DM) + RMS_EPS);
    v2u* o8 = (v2u*)orow + lane;
#pragma unroll
    for (int j = 0; j < 8; ++j) { const f32x4 g = gr[64 * j]; v2u w; w.x = pk2(v[j].x * rs * g.x, v[j].y * rs * g.y); w.y = pk2(v[j].z * rs * g.z, v[j].w * rs * g.w); o8[64 * j] = w; }
}
template <bool WITH_XN>
__device__ __forceinline__ void residual_row(const bf16* yrow, const float* g1, const float* hbase, float* hout, const float* g2, bf16* xnrow, int lane) {
    float v[32]; float s = 0.f;
#pragma unroll
    for (int j = 0; j < 4; ++j) { const v4u w = *((const v4u*)yrow + lane + 64 * j);
        v[8 * j + 0] = bflo(w.x); v[8 * j + 1] = bfhi(w.x); v[8 * j + 2] = bflo(w.y); v[8 * j + 3] = bfhi(w.y); v[8 * j + 4] = bflo(w.z); v[8 * j + 5] = bfhi(w.z); v[8 * j + 6] = bflo(w.w); v[8 * j + 7] = bfhi(w.w); }
#pragma unroll
    for (int i = 0; i < 32; ++i) s += v[i] * v[i];
    const float rs = 1.0f / sqrtf(wave_sum(s) * (1.0f / DM) + RMS_EPS);
    float s2 = 0.f;
#pragma unroll
    for (int j = 0; j < 4; ++j) { const int e0 = (lane + 64 * j) * 8;
#pragma unroll
        for (int q = 0; q < 2; ++q) { const f32x4 g = *(const f32x4*)(g1 + e0 + 4 * q); const f32x4 b = *(const f32x4*)(hbase + e0 + 4 * q); f32x4 o;
            o.x = b.x + v[8 * j + 4 * q] * rs * g.x; o.y = b.y + v[8 * j + 4 * q + 1] * rs * g.y; o.z = b.z + v[8 * j + 4 * q + 2] * rs * g.z; o.w = b.w + v[8 * j + 4 * q + 3] * rs * g.w;
            *(f32x4*)(hout + e0 + 4 * q) = o; v[8 * j + 4 * q] = o.x; v[8 * j + 4 * q + 1] = o.y; v[8 * j + 4 * q + 2] = o.z; v[8 * j + 4 * q + 3] = o.w;
            s2 += (o.x * o.x + o.y * o.y) + (o.z * o.z + o.w * o.w); } }
    if (WITH_XN) {
        const float rs2 = 1.0f / sqrtf(wave_sum(s2) * (1.0f / DM) + RMS_EPS);
#pragma unroll
        for (int j = 0; j < 4; ++j) { const int e0 = (lane + 64 * j) * 8; const f32x4 ga = *(const f32x4*)(g2 + e0), gb = *(const f32x4*)(g2 + e0 + 4);
            *((v4u*)xnrow + lane + 64 * j) = (v4u){pk2(v[8 * j] * rs2 * ga.x, v[8 * j + 1] * rs2 * ga.y), pk2(v[8 * j + 2] * rs2 * ga.z, v[8 * j + 3] * rs2 * ga.w),
                                                    pk2(v[8 * j + 4] * rs2 * gb.x, v[8 * j + 5] * rs2 * gb.y), pk2(v[8 * j + 6] * rs2 * gb.z, v[8 * j + 7] * rs2 * gb.w)}; }
    }
}
__device__ __forceinline__ void cexp_lam(double lr, double li, double dt, double& ar, double& ai) {
    const double x = lr * dt;
    double e = 1.0; { double term = 1.0; for (int k = 1; k <= 14; ++k) { term *= x / (double)k; e += term; } }
    double th = li * dt;
    const double TWO_PI_HI = 6.283185307179586, TWO_PI_LO = 2.4492935982947064e-16;
    const double kq = rint(th * 0.15915494309189535); th = (th - kq * TWO_PI_HI) - kq * TWO_PI_LO;
    const double y = th * 0.0625, y2 = y * y;
    double s = y * (1.0 - y2 / 6.0 * (1.0 - y2 / 20.0 * (1.0 - y2 / 42.0 * (1.0 - y2 / 72.0 * (1.0 - y2 / 110.0 * (1.0 - y2 / 156.0))))));
    double c = 1.0 - y2 / 2.0 * (1.0 - y2 / 12.0 * (1.0 - y2 / 30.0 * (1.0 - y2 / 56.0 * (1.0 - y2 / 90.0 * (1.0 - y2 / 132.0)))));
#pragma unroll
    for (int k = 0; k < 4; ++k) { const double s2 = 2.0 * s * c, c2 = c * c - s * s; s = s2; c = c2; }
    ar = e * c; ai = e * s;
}
__device__ __forceinline__ double exp_f64(double x) {
    const double kq = rint(x * 1.4426950408889634); const double r = (x - kq * 0.6931471803691238) - kq * 1.9082149292705877e-10;
    double e = 1.0, term = 1.0; for (int k = 1; k <= 16; ++k) { term *= r / (double)k; e += term; }
    const long long bits = (long long)(1023 + (int)kq) << 52; return e * __builtin_bit_cast(double, bits);
}

__device__ __forceinline__ int crow(int reg, int h) { return (reg & 3) + 8 * (reg >> 2) + 4 * h; }
#define MFMA32(a, b, c) __builtin_amdgcn_mfma_f32_32x32x16_bf16((a), (b), (c), 0, 0, 0)
constexpr int VROW = 272;
__device__ __forceinline__ void attn_wave_unit(int wu, const bf16* Q, const bf16* K, const bf16* V, bf16* OB, float* LSE, LAS unsigned char* vbuf, int lane) {
    const int sub = wu & 3, blk = (wu >> 2) & 31, h = (wu >> 7) & 7, b = (wu >> 10) & 1, br = wu >> 11;
    const int dsh = 2 * br, d = 1 << dsh, nbm = (32 >> dsh) - 1, r = blk >> (5 - dsh), n = blk & nbm;
    const int iq = lane & 31, hh = lane >> 5;
    const int m0 = n * 128 + sub * 32;
    const size_t tokq = (size_t)b * SEQ + (size_t)(m0 + iq) * d + r;
    const int jmin = (n == 0) ? (4 - sub) : 0;
    const bf16* kbase = K + ((size_t)b * SEQ + r) * AW + h * 128 + hh * 8;
    const bf16* vbase = V + ((size_t)b * SEQ + r) * AW + h * 128 + (lane & 15) * 8;
    const size_t rstep = (size_t)d * AW;
    bf16x8 qf[8], kf[8]; v4u vst[8];
    { const bf16* qrow = Q + tokq * AW + h * 128 + hh * 8;
#pragma unroll
      for (int kk = 0; kk < 8; ++kk) qf[kk] = *(const bf16x8*)(qrow + kk * 16); }
    { const int kb = m0 - 128 + 32 * jmin; const bf16* krow = kbase + (size_t)(kb + iq) * rstep;
#pragma unroll
      for (int kk = 0; kk < 8; ++kk) kf[kk] = *(const bf16x8*)(krow + kk * 16);
#pragma unroll
      for (int it = 0; it < 8; ++it) vst[it] = *(const v4u*)(vbase + (size_t)(kb + it * 4 + (lane >> 4)) * rstep);
#pragma unroll
      for (int it = 0; it < 8; ++it) *(LAS v4u*)(vbuf + (it * 4 + (lane >> 4)) * VROW + (lane & 15) * 16) = vst[it]; }
    f32x16 o[4];
#pragma unroll
    for (int dt = 0; dt < 4; ++dt)
#pragma unroll
        for (int i = 0; i < 16; ++i) o[dt][i] = 0.f;
    float rmax = -1e30f, rsum = 0.f;
    for (int j = jmin; j <= 4; ++j) {
        LAS unsigned char* vcur = vbuf + ((j - jmin) & 1) * (32 * VROW);
        LAS unsigned char* vnxt = vbuf + (((j - jmin) & 1) ^ 1) * (32 * VROW);
        f32x16 st;
#pragma unroll
        for (int i = 0; i < 16; ++i) st[i] = 0.f;
#pragma unroll
        for (int kk = 0; kk < 8; ++kk) st = MFMA32(kf[kk], qf[kk], st);
        if (j < 4) {
            const int kb = m0 - 128 + 32 * (j + 1); const bf16* krow = kbase + (size_t)(kb + iq) * rstep;
#pragma unroll
            for (int kk = 0; kk < 8; ++kk) kf[kk] = *(const bf16x8*)(krow + kk * 16);
#pragma unroll
            for (int it = 0; it < 8; ++it) vst[it] = *(const v4u*)(vbase + (size_t)(kb + it * 4 + (lane >> 4)) * rstep);
        }
        if (j == 0) {
#pragma unroll
            for (int i = 0; i < 16; ++i) if (crow(i, hh) < iq) st[i] = -1e30f;
        }
        if (j == 4) {
#pragma unroll
            for (int i = 0; i < 16; ++i) if (crow(i, hh) > iq) st[i] = -1e30f;
        }
        float tmax = st[0];
#pragma unroll
        for (int i = 1; i < 16; ++i) tmax = fmaxf(tmax, st[i]);
        tmax = fmaxf(tmax, __shfl_xor(tmax, 32));
        const float nmax = fmaxf(rmax, tmax);
        const float alpha = __builtin_amdgcn_exp2f(rmax - nmax);
        rmax = nmax;
        float psum = 0.f;
#pragma unroll
        for (int i = 0; i < 16; ++i) { st[i] = __builtin_amdgcn_exp2f(st[i] - nmax); psum += st[i]; }
        rsum = rsum * alpha + psum;
#pragma unroll
        for (int dt = 0; dt < 4; ++dt)
#pragma unroll
            for (int i = 0; i < 16; ++i) o[dt][i] *= alpha;
        LDS_WAIT();
#pragma unroll
        for (int s = 0; s < 2; ++s) {
            bf16x8 pf;
#pragma unroll
            for (int e = 0; e < 8; ++e) pf[e] = (short)f2bf(st[8 * s + e]);
#pragma unroll
            for (int dt = 0; dt < 4; ++dt) {
                bf16x8 vf;
#pragma unroll
                for (int e = 0; e < 8; ++e) vf[e] = *(const LAS short*)(vcur + crow(8 * s + e, hh) * VROW + (dt * 32 + iq) * 2);
                o[dt] = MFMA32(vf, pf, o[dt]);
            }
        }
        if (j < 4) {
#pragma unroll
            for (int it = 0; it < 8; ++it) *(LAS v4u*)(vnxt + (it * 4 + (lane >> 4)) * VROW + (lane & 15) * 16) = vst[it];
        }
    }
    LDS_WAIT();
    const float tot = rsum + __shfl_xor(rsum, 32);
    const float inv = 1.0f / tot;
    bf16* orow = OB + (size_t)br * OB_STRIDE + tokq * AW + h * 128 + 4 * hh;
#pragma unroll
    for (int dt = 0; dt < 4; ++dt)
#pragma unroll
        for (int gq = 0; gq < 4; ++gq) { v2u w; w.x = pk2(o[dt][4 * gq] * inv, o[dt][4 * gq + 1] * inv); w.y = pk2(o[dt][4 * gq + 2] * inv, o[dt][4 * gq + 3] * inv);
            *(v2u*)(orow + dt * 32 + 8 * gq) = w; }
    if (hh == 0) LSE[((size_t)br * M_TOK + tokq) * NH + h] = rmax + __log2f(tot);
}

#define XB_TMO      128
#define XB_XCNT(j)  (256  + 64 * (j))
#define XB_XSUB(j)  (1280 + 64 * (j))
#define XB_XGEN(j)  (2304 + 64 * (j))
#define XB_TOP      3328
#define XB_TOPGEN   3392
#define XCD_BAR_WORDS 3456
#define XB_SPIN_CAP (1u << 18)

__device__ __forceinline__ unsigned xb_ld(unsigned* p)              { return __hip_atomic_load(p, __ATOMIC_RELAXED, __HIP_MEMORY_SCOPE_AGENT); }
__device__ __forceinline__ unsigned xb_add(unsigned* p, unsigned v) { return __hip_atomic_fetch_add(p, v, __ATOMIC_RELAXED, __HIP_MEMORY_SCOPE_AGENT); }
__device__ __forceinline__ unsigned xb_xcc_id() { return (unsigned)__builtin_amdgcn_s_getreg((3 << 11) | 20) & 0xFu; }
#define XB_SPIN(cond, bar) do { unsigned _sp = 0; while (cond) { __builtin_amdgcn_s_sleep(1); \
    if ((++_sp & 255u) == 0u) { if (xb_ld(&(bar)[XB_TMO])) break; if (_sp > XB_SPIN_CAP) { atomicAdd(&(bar)[XB_TMO], 1u); break; } } } } while (0)

struct XcdBarrier {
    unsigned* bar; unsigned x;
    volatile LAS unsigned* st;
};

__device__ __forceinline__ XcdBarrier xcd_barrier_post(unsigned* bar, volatile LAS unsigned* st) {
    XcdBarrier b; b.bar = bar; b.x = xb_xcc_id(); b.st = st;
    if (threadIdx.x == 0) (void)xb_add(&bar[XB_XCNT(b.x)], 1u);
    return b;
}
__device__ __forceinline__ void xcd_barrier_complete(unsigned* bar, unsigned x, unsigned& nloc, unsigned& nx) {
    const unsigned G = gridDim.x * gridDim.y * gridDim.z;
    unsigned sum, cnt, mine, sp = 0u;
    for (;;) {
        sum = 0u; cnt = 0u; mine = 0u;
#pragma unroll
        for (unsigned j = 0; j < 16; ++j) { const unsigned c = xb_ld(&bar[XB_XCNT(j)]); sum += c; cnt += (c > 0u) ? 1u : 0u; mine = (j == x) ? c : mine; }
        if (sum == G) break;
        __builtin_amdgcn_s_sleep(1);
        if ((++sp & 255u) == 0u) { if (xb_ld(&bar[XB_TMO])) break; if (sp > XB_SPIN_CAP) { atomicAdd(&bar[XB_TMO], 1u); break; } }
    }
    nloc = mine > 0u ? mine : 1u; nx = cnt > 0u ? cnt : 1u;
}

__device__ __forceinline__ void xcd_barrier(const XcdBarrier& b) {
    asm volatile("s_waitcnt vmcnt(0)" ::: "memory");
    __syncthreads();
    if (threadIdx.x == 0) {
        unsigned* bar = b.bar;
        __builtin_amdgcn_s_waitcnt(0);
        unsigned nloc = b.st[0], nx = b.st[1];
        if (nloc == 0u) { xcd_barrier_complete(bar, b.x, nloc, nx); b.st[0] = nloc; b.st[1] = nx; }
        const unsigned old = xb_add(&bar[XB_XSUB(b.x)], 1u);
        const unsigned gen = old / nloc;
        if (old + 1u == (gen + 1u) * nloc) {
            __builtin_amdgcn_fence(__ATOMIC_RELEASE, "agent");
            asm volatile("s_waitcnt vmcnt(0)" ::: "memory");
            const unsigned og = xb_add(&bar[XB_TOP], 1u);
            const unsigned tg = og / nx;
            if (og + 1u == (tg + 1u) * nx) xb_add(&bar[XB_TOPGEN], 1u);
            else XB_SPIN(xb_ld(&bar[XB_TOPGEN]) == tg, bar);
            __builtin_amdgcn_fence(__ATOMIC_ACQUIRE, "agent");
            xb_add(&bar[XB_XGEN(b.x)], 1u);
            asm volatile("s_waitcnt vmcnt(0)" ::: "memory");
        } else {
            XB_SPIN(xb_ld(&bar[XB_XGEN(b.x)]) == gen, bar);
            __builtin_amdgcn_fence(__ATOMIC_ACQUIRE, "agent");
            asm volatile("s_waitcnt vmcnt(0)" ::: "memory");
        }
    }
    __syncthreads();
}

struct Args {
    const float *x, *p, *mix_norm_pre, *w_in, *lam_re, *lam_im, *log_dt, *b_re, *b_im, *c_re, *c_im, *ssm_d, *w_glu, *b_glu, *attn_norm, *ssm_norm,
                *w_out, *mix_norm_post, *mlp_norm_pre, *w_up, *w_down, *mlp_norm_post, *ple_norm_pre, *w_g, *w_p, *ple_norm_post;
    float* out; unsigned char* ws; int ph_lo, ph_hi;
};
constexpr int N_PHASES = 12;
#ifndef REP_MASK
#define REP_MASK 0
#endif

__global__ void __launch_bounds__(NTHREADS, 2) fwd_megakernel(Args a) {
    extern __shared__ __attribute__((aligned(16))) unsigned char lds_raw[];
    LAS unsigned char* lds = (LAS unsigned char*)lds_raw;
    const int tid = threadIdx.x, lane = tid & 63, wave = __builtin_amdgcn_readfirstlane(tid >> 6);
    const int G = gridDim.x, bx = blockIdx.x;
    const int vcu = (G % 8 == 0) ? (bx % 8) * (G / 8) + bx / 8 : bx;
    const int gw = vcu * NWAVES + wave, NGW = G * NWAVES;
    const int gt = vcu * NTHREADS + tid, NGT = G * NTHREADS;
    unsigned char* ws = a.ws;
    bf16* XN = (bf16*)(ws + WS_XN);
    const int lo = a.ph_lo, hi = a.ph_hi;
#define IN(k) (lo <= (k) && (k) < hi)
    volatile LAS unsigned* MISC = (volatile LAS unsigned*)(lds + LDS_BYTES - 256);
    if (tid < 32) MISC[tid] = 0u;
    __syncthreads();
    if (lo < 0) cg::this_grid().sync();
    XcdBarrier bar = xcd_barrier_post((unsigned*)ws, MISC + 8);
#define GSYNC() xcd_barrier(bar)
#define SEAM(k) do { if (IN(k) && IN((k) + 1)) GSYNC(); } while (0)
#define PH_BEGIN(k) for (int rep_ = 0; rep_ < (IN(k) ? 1 + ((REP_MASK >> (k)) & 1) : 0); ++rep_) { if (rep_) GSYNC();
    LAS float* scr = (LAS float*)(lds + wave * 16384);

    PH_BEGIN(0)
        constexpr int I_IN = (DM / 64) * (NPROJ / 32), I_GLU = (AW / 64) * (AW / 32), I_OUT = (DM / 64) * (DM / 32);
        for (int it = gw; it < I_IN + I_GLU + I_OUT; it += NGW) {
            int r = it;
            if (r < I_IN) { transpose_item(a.w_in, DM, NPROJ, (bf16*)(ws + WS_WIN), scr, r, lane); continue; } r -= I_IN;
            if (r < I_GLU) { transpose_item(a.w_glu, AW, AW, (bf16*)(ws + WS_WGLU), scr, r, lane); continue; } r -= I_GLU;
            transpose_item(a.w_out, DM, DM, (bf16*)(ws + WS_WOUT), scr, r, lane);
        }
        for (int m = gw; m < M_TOK; m += NGW) rms_row_to_bf16(a.x + (size_t)m * DM, a.mix_norm_pre, XN + (size_t)m * DM, lane);
        for (int id = gt; id < SG * SP; id += NGT) {
            const int g = id >> 6;
            const double lr = (double)a.lam_re[id], li = (double)a.lam_im[id], dt = exp_f64((double)a.log_dt[g]);
            double ar, ai; cexp_lam(lr, li, dt, ar, ai);
            f32x2* pw = (f32x2*)(ws + WS_PW) + (size_t)id * 33;
            double pr = 1.0, pi = 0.0;
            for (int t = 0; t <= 32; ++t) { pw[t] = (f32x2){(float)pr, (float)pi}; const double nr = pr * ar - pi * ai, ni = pr * ai + pi * ar; pr = nr; pi = ni; }
            const double nr = ar - 1.0, ni = ai, den = lr * lr + li * li;
            const double cr = (nr * lr + ni * li) / den, ci = (ni * lr - nr * li) / den;
            f32x2* bb = (f32x2*)(ws + WS_BBAR) + (size_t)id * 16;
            for (int c = 0; c < SC; ++c) { const double br_ = (double)a.b_re[(size_t)id * 16 + c], bi_ = (double)a.b_im[(size_t)id * 16 + c];
                bb[c] = (f32x2){(float)(cr * br_ - ci * bi_), (float)(cr * bi_ + ci * br_)}; }
        }
    }
    SEAM(0);
    PH_BEGIN(1)
        { pg8::Gemm g{XN, (const bf16*)(ws + WS_WIN), M_TOK, NPROJ, DM, DM, DM}; pg8::StaticOrder S; S.init(M_TOK, NPROJ, G, bx);
          pg8::EpiProj E{(bf16*)(ws + WS_Q), (size_t)(WS_K - WS_Q) / 2, (bf16*)(ws + WS_UG), QSCALE};
          static_assert(WS_V - WS_K == WS_K - WS_Q, "q, k, v equally spaced");
          pg8::gemm_phase<pg8::EpiProj, pg8::StaticOrder, true, true>(lds, g, S, E); }
        const f32x2* PW = (const f32x2*)(ws + WS_PW); const f32x2* BB = (const f32x2*)(ws + WS_BBAR);
        for (int id = gt; id < SG * 256 * CHL; id += NGT) {
            const int tp = id & 31, q = (id >> 5) & 255, g = id >> 13;
            bf16* dst = (bf16*)(ws + WS_HST) + ((size_t)(g * 256 + q)) * 512 + tp * 16;
            v4u w0 = (v4u){0u, 0u, 0u, 0u}, w1 = w0;
            if (q < 128) { const int p = q & 63, part = q >> 6; const f32x2 pw = PW[(size_t)(g * 64 + p) * 33 + (31 - tp)]; const f32x2* bb = BB + (size_t)(g * 64 + p) * 16;
                float v[16];
#pragma unroll
                for (int c = 0; c < 16; ++c) { const f32x2 b_ = bb[c]; v[c] = part == 0 ? (b_.x * pw.x - b_.y * pw.y) : (b_.x * pw.y + b_.y * pw.x); }
                w0 = (v4u){pk2(v[0], v[1]), pk2(v[2], v[3]), pk2(v[4], v[5]), pk2(v[6], v[7])}; w1 = (v4u){pk2(v[8], v[9]), pk2(v[10], v[11]), pk2(v[12], v[13]), pk2(v[14], v[15])}; }
            *(v4u*)dst = w0; *(v4u*)(dst + 8) = w1;
        }
        for (int w = bx; w < SG * 4; w += G) {
            const int g = w >> 2, q = w & 3;
            LAS f32x2* Cs = (LAS f32x2*)lds; LAS f32x2* Bs = (LAS f32x2*)(lds + 8192); LAS f32x2* Ps = (LAS f32x2*)(lds + 16384); LAS float* KTs = (LAS float*)(lds + 20480);
            __syncthreads();
#pragma unroll
            for (int e = 0; e < 2; ++e) { const int i = tid + e * NTHREADS; Cs[i] = (f32x2){a.c_re[(size_t)g * 1024 + i], a.c_im[(size_t)g * 1024 + i]}; Bs[i] = BB[(size_t)g * 1024 + i]; }
            Ps[tid] = PW[(size_t)(g * 64 + (tid >> 3)) * 33 + 8 * q + (tid & 7)];
            __syncthreads();
            { const int cc = tid & 255, c = cc >> 4, cp = cc & 15, th = tid >> 8;
              float acc[4] = {0.f, 0.f, 0.f, 0.f};
#pragma unroll 4
              for (int p = 0; p < SP; ++p) { const f32x2 cv = Cs[c * 64 + p], bv = Bs[p * 16 + cp];
#pragma unroll
                  for (int k = 0; k < 4; ++k) { const f32x2 pw = Ps[p * 8 + 4 * th + k]; const float wr = cv.x * pw.x - cv.y * pw.y, wi = cv.x * pw.y + cv.y * pw.x; acc[k] += wr * bv.x - wi * bv.y; } }
#pragma unroll
              for (int k = 0; k < 4; ++k) KTs[(4 * th + k) * 256 + cc] = acc[k]; }
            __syncthreads();
            { const int t = tid >> 4, c = tid & 15; bf16* rowp = (bf16*)(ws + WS_BSB) + ((size_t)(g * 512 + tid)) * UGK;
#pragma unroll
              for (int k = 0; k < 8; ++k) {
                  const int tp = t - (8 * q + k);
                  if (tp >= 0) { const LAS f32x4* kt = (const LAS f32x4*)(KTs + k * 256 + c * 16); const f32x4 k0 = kt[0], k1 = kt[1], k2 = kt[2], k3 = kt[3];
                      *(v4u*)(rowp + tp * 16) = (v4u){pk2(k0.x, k0.y), pk2(k0.z, k0.w), pk2(k1.x, k1.y), pk2(k1.z, k1.w)};
                      *(v4u*)(rowp + tp * 16 + 8) = (v4u){pk2(k2.x, k2.y), pk2(k2.z, k2.w), pk2(k3.x, k3.y), pk2(k3.z, k3.w)}; }
                  const int tz = t + 1 + 8 * q + k;
                  if (tz < CHL) { *(v4u*)(rowp + tz * 16) = (v4u){0u, 0u, 0u, 0u}; *(v4u*)(rowp + tz * 16 + 8) = (v4u){0u, 0u, 0u, 0u}; }
              } }
        }
        for (int id = gt; id < SG * 512 * 8; id += NGT) {
            const int qb = id & 7, rest = id >> 3, c = rest & 15, t = (rest >> 4) & 31, g = rest >> 9;
            bf16* dst = (bf16*)(ws + WS_BSB) + ((size_t)(g * 512 + t * 16 + c)) * UGK + 512 + qb * 16;
            float v[16];
#pragma unroll
            for (int i = 0; i < 16; ++i) { const int comp = qb * 16 + i, part = comp >> 6, p = comp & 63; const f32x2 pw = PW[(size_t)(g * 64 + p) * 33 + t + 1];
                const float cr = a.c_re[(size_t)(g * 16 + c) * 64 + p], ci = a.c_im[(size_t)(g * 16 + c) * 64 + p];
                v[i] = part == 0 ? (cr * pw.x - ci * pw.y) : -(cr * pw.y + ci * pw.x); }
            *(v4u*)dst = (v4u){pk2(v[0], v[1]), pk2(v[2], v[3]), pk2(v[4], v[5]), pk2(v[6], v[7])};
            *(v4u*)(dst + 8) = (v4u){pk2(v[8], v[9]), pk2(v[10], v[11]), pk2(v[12], v[13]), pk2(v[14], v[15])};
        }
    }
    SEAM(1);
    PH_BEGIN(2)
        if (bx < SG) {
            { pg8::Gemm g{(const bf16*)(ws + WS_UG), (const bf16*)(ws + WS_HST), SG * 256, SG * 256, 512, UGK, 512}; pg8::StateOrder S{SG, G, bx};
              pg8::EpiE E{(float*)(ws + WS_E)};
              pg8::gemm_phase<pg8::EpiE, pg8::StateOrder, true, true>(lds, g, S, E); }
            asm volatile("s_waitcnt vmcnt(0)" ::: "memory"); __syncthreads(); __builtin_amdgcn_fence(__ATOMIC_ACQUIRE, "agent");
            for (int g = bx; g < SG; g += G) {
                if (wave < 2) {
                    const int b = wave, p = lane;
                    const f32x2 a32 = ((const f32x2*)(ws + WS_PW))[(size_t)(g * 64 + p) * 33 + 32];
                    const float* E = (const float*)(ws + WS_E) + ((size_t)(g * 256 + b * 128)) * 128; bf16* ug = (bf16*)(ws + WS_UG) + ((size_t)(g * 256 + b * 128)) * UGK + 512;
                    float sr = 0.f, si = 0.f;
                    for (int c0 = 0; c0 < 128; c0 += 32) {
                        float er[32], ei[32];
#pragma unroll
                        for (int k = 0; k < 32; ++k) { er[k] = E[(size_t)(c0 + k) * 128 + p]; ei[k] = E[(size_t)(c0 + k) * 128 + 64 + p]; }
#pragma unroll
                        for (int k = 0; k < 32; ++k) {
                            ug[(size_t)(c0 + k) * UGK + p] = (bf16)f2bf(sr); ug[(size_t)(c0 + k) * UGK + 64 + p] = (bf16)f2bf(si);
                            const float nr = a32.x * sr - a32.y * si + er[k], ni = a32.x * si + a32.y * sr + ei[k]; sr = nr; si = ni; }
                    }
                }
            }
            asm volatile("s_waitcnt vmcnt(0)" ::: "memory"); __syncthreads(); __builtin_amdgcn_fence(__ATOMIC_ACQUIRE, "agent");
            { pg8::Gemm g{(const bf16*)(ws + WS_UG), (const bf16*)(ws + WS_BSB), SG * 256, SG * 512, UGK, UGK, UGK}; pg8::OutOrder S{SG, G, bx};
              pg8::EpiY E{(const bf16*)(ws + WS_UG), a.ssm_d, (bf16*)(ws + WS_YB)};
              pg8::gemm_phase<pg8::EpiY, pg8::OutOrder, true, true>(lds, g, S, E); }
        }
        {
            unsigned* ctr = (unsigned*)(ws + 49152);
            for (;;) {
                unsigned wu = 0u; if (lane == 0) wu = __hip_atomic_fetch_add(ctr, 1u, __ATOMIC_RELAXED, __HIP_MEMORY_SCOPE_AGENT);
                wu = (unsigned)__builtin_amdgcn_readfirstlane((int)wu);
                if (wu >= 3u * 2u * NH * 32u * 4u) break;
                attn_wave_unit((int)wu, (const bf16*)(ws + WS_Q), (const bf16*)(ws + WS_K), (const bf16*)(ws + WS_V), (bf16*)(ws + WS_OB), (float*)(ws + WS_LSE), lds + wave * 17408, lane);
            }
        }
    }
    SEAM(2);
    PH_BEGIN(3)
        { pg8::Gemm g{(const bf16*)(ws + WS_YB), (const bf16*)(ws + WS_WGLU), M_TOK, AW, AW, AW, AW}; pg8::StaticOrder S; S.init(M_TOK, AW, G, bx);
          pg8::EpiGLU E{(const bf16*)(ws + WS_YB), a.b_glu, (bf16*)(ws + WS_SSMO)};
          pg8::gemm_phase<pg8::EpiGLU, pg8::StaticOrder, true, true>(lds, g, S, E); }
        const int nglu = (M_TOK / 256) * (AW / 256);
        const int r0 = (G > nglu) ? nglu : 0;
        if (bx >= r0) {
            const bf16* OB = (const bf16*)(ws + WS_OB); const float* LSE = (const float*)(ws + WS_LSE);
            for (int m = (bx - r0) * NWAVES + wave; m < M_TOK; m += (G - r0) * NWAVES) {
                const int h = lane >> 3;
                const float l0 = LSE[((size_t)0 * M_TOK + m) * NH + h], l1 = LSE[((size_t)1 * M_TOK + m) * NH + h], l2 = LSE[((size_t)2 * M_TOK + m) * NH + h];
                const float mx = fmaxf(l0, fmaxf(l1, l2));
                float w0 = __builtin_amdgcn_exp2f(l0 - mx), w1 = __builtin_amdgcn_exp2f(l1 - mx), w2 = __builtin_amdgcn_exp2f(l2 - mx);
                const float wi = 1.0f / (w0 + w1 + w2); w0 *= wi; w1 *= wi; w2 *= wi;
                float v[16]; float s = 0.f;
#pragma unroll
                for (int hf = 0; hf < 2; ++hf) {
                    const size_t off = (size_t)m * AW + lane * 16 + hf * 8;
                    const v4u x0 = *(const v4u*)(OB + off), x1 = *(const v4u*)(OB + OB_STRIDE + off), x2 = *(const v4u*)(OB + 2 * OB_STRIDE + off);
                    v[hf * 8 + 0] = w0 * bflo(x0.x) + w1 * bflo(x1.x) + w2 * bflo(x2.x); v[hf * 8 + 1] = w0 * bfhi(x0.x) + w1 * bfhi(x1.x) + w2 * bfhi(x2.x);
                    v[hf * 8 + 2] = w0 * bflo(x0.y) + w1 * bflo(x1.y) + w2 * bflo(x2.y); v[hf * 8 + 3] = w0 * bfhi(x0.y) + w1 * bfhi(x1.y) + w2 * bfhi(x2.y);
                    v[hf * 8 + 4] = w0 * bflo(x0.z) + w1 * bflo(x1.z) + w2 * bflo(x2.z); v[hf * 8 + 5] = w0 * bfhi(x0.z) + w1 * bfhi(x1.z) + w2 * bfhi(x2.z);
                    v[hf * 8 + 6] = w0 * bflo(x0.w) + w1 * bflo(x1.w) + w2 * bflo(x2.w); v[hf * 8 + 7] = w0 * bfhi(x0.w) + w1 * bfhi(x1.w) + w2 * bfhi(x2.w);
                }
#pragma unroll
                for (int i = 0; i < 16; ++i) s += v[i] * v[i];
                const float rs = 1.0f / sqrtf(wave_sum(s) * (1.0f / AW) + RMS_EPS);
                bf16* xo = XN + (size_t)m * DM + lane * 16;
#pragma unroll
                for (int hf = 0; hf < 2; ++hf) { const f32x4 g0 = *(const f32x4*)(a.attn_norm + lane * 16 + hf * 8), g1 = *(const f32x4*)(a.attn_norm + lane * 16 + hf * 8 + 4);
                    *(v4u*)(xo + hf * 8) = (v4u){pk2(v[hf * 8] * rs * g0.x, v[hf * 8 + 1] * rs * g0.y), pk2(v[hf * 8 + 2] * rs * g0.z, v[hf * 8 + 3] * rs * g0.w),
                                                 pk2(v[hf * 8 + 4] * rs * g1.x, v[hf * 8 + 5] * rs * g1.y), pk2(v[hf * 8 + 6] * rs * g1.z, v[hf * 8 + 7] * rs * g1.w)}; }
            }
        }
    }
    SEAM(3);
    PH_BEGIN(4)
        const bf16* SO = (const bf16*)(ws + WS_SSMO);
        for (int m = gw; m < M_TOK; m += NGW) {
            float v[16]; float s = 0.f;
#pragma unroll
            for (int hf = 0; hf < 2; ++hf) { const v4u x0 = *(const v4u*)(SO + (size_t)m * AW + lane * 16 + hf * 8);
                v[hf * 8 + 0] = bflo(x0.x); v[hf * 8 + 1] = bfhi(x0.x); v[hf * 8 + 2] = bflo(x0.y); v[hf * 8 + 3] = bfhi(x0.y);
                v[hf * 8 + 4] = bflo(x0.z); v[hf * 8 + 5] = bfhi(x0.z); v[hf * 8 + 6] = bflo(x0.w); v[hf * 8 + 7] = bfhi(x0.w); }
#pragma unroll
            for (int i = 0; i < 16; ++i) s += v[i] * v[i];
            const float rs = 1.0f / sqrtf(wave_sum(s) * (1.0f / AW) + RMS_EPS);
            bf16* xo = XN + (size_t)m * DM + AW + lane * 16;
#pragma unroll
            for (int hf = 0; hf < 2; ++hf) { const f32x4 g0 = *(const f32x4*)(a.ssm_norm + lane * 16 + hf * 8), g1 = *(const f32x4*)(a.ssm_norm + lane * 16 + hf * 8 + 4);
                *(v4u*)(xo + hf * 8) = (v4u){pk2(v[hf * 8] * rs * g0.x, v[hf * 8 + 1] * rs * g0.y), pk2(v[hf * 8 + 2] * rs * g0.z, v[hf * 8 + 3] * rs * g0.w),
                                             pk2(v[hf * 8 + 4] * rs * g1.x, v[hf * 8 + 5] * rs * g1.y), pk2(v[hf * 8 + 6] * rs * g1.z, v[hf * 8 + 7] * rs * g1.w)}; }
        }
    }
    SEAM(4);
    PH_BEGIN(5)
        pg8::Gemm g{XN, (const bf16*)(ws + WS_WOUT), M_TOK, DM, DM, DM, DM}; pg8::StaticOrder S; S.init(M_TOK, DM, G, bx);
        pg8::EpiBf16Plain E{(bf16*)(ws + WS_MIX), DM};
        pg8::gemm_phase<pg8::EpiBf16Plain, pg8::StaticOrder, true, true>(lds, g, S, E);
    }
    SEAM(5);
    PH_BEGIN(6)
        for (int m = gw; m < M_TOK; m += NGW)
            residual_row<true>((const bf16*)(ws + WS_MIX) + (size_t)m * DM, a.mix_norm_post, a.x + (size_t)m * DM, a.out + (size_t)m * DM, a.mlp_norm_pre, XN + (size_t)m * DM, lane);
        constexpr int I_UP = (DM / 64) * (DFF / 32), I_DOWN = (DFF / 64) * (DM / 32), I_G = (DM / 64) * (DM / 32), I_P = (PLE / 64) * (DM / 32);
        for (int it = gw; it < I_UP + I_DOWN + I_G + I_P; it += NGW) {
            int r = it;
            if (r < I_UP) { transpose_item(a.w_up, DM, DFF, (bf16*)(ws + WS_WUP), scr, r, lane); continue; } r -= I_UP;
            if (r < I_DOWN) { transpose_item(a.w_down, DFF, DM, (bf16*)(ws + WS_WDOWN), scr, r, lane); continue; } r -= I_DOWN;
            if (r < I_G) { transpose_item(a.w_g, DM, DM, (bf16*)(ws + WS_WG), scr, r, lane); continue; } r -= I_G;
            transpose_item(a.w_p, PLE, DM, (bf16*)(ws + WS_WP), scr, r, lane);
        }
        for (int id = gt; id < M_TOK * PLE / 4; id += NGT) { const f32x4 v = ((const f32x4*)a.p)[id]; ((v2u*)(ws + WS_PB))[id] = (v2u){pk2(v.x, v.y), pk2(v.z, v.w)}; }
    }
    SEAM(6);
    PH_BEGIN(7)
        pg8::Gemm g{XN, (const bf16*)(ws + WS_WUP), M_TOK, DFF, DM, DM, DM}; pg8::StaticOrder S; S.init(M_TOK, DFF, G, bx);
        pg8::EpiRelu2 E{(bf16*)(ws + WS_HID), DFF};
        pg8::gemm_phase<pg8::EpiRelu2, pg8::StaticOrder, true, true>(lds, g, S, E);
    }
    SEAM(7);
    PH_BEGIN(8)
        pg8::Gemm g{(const bf16*)(ws + WS_HID), (const bf16*)(ws + WS_WDOWN), M_TOK, DM, DFF, DFF, DFF}; pg8::StaticOrder S; S.init(M_TOK, DM, G, bx);
        pg8::EpiBf16Plain E{(bf16*)(ws + WS_FF), DM};
        pg8::gemm_phase<pg8::EpiBf16Plain, pg8::StaticOrder, true, true>(lds, g, S, E);
    }
    SEAM(8);
    PH_BEGIN(9)
        { pg8::Gemm g{(const bf16*)(ws + WS_PB), (const bf16*)(ws + WS_WP), M_TOK, DM, PLE, PLE, PLE}; pg8::StaticOrder S; S.init(M_TOK, DM, G, bx);
          pg8::EpiBf16Plain E{(bf16*)(ws + WS_GE), DM};
          pg8::gemm_phase<pg8::EpiBf16Plain, pg8::StaticOrder, true, true>(lds, g, S, E); }
        for (int m = gw; m < M_TOK; m += NGW)
            residual_row<true>((const bf16*)(ws + WS_FF) + (size_t)m * DM, a.mlp_norm_post, a.out + (size_t)m * DM, a.out + (size_t)m * DM, a.ple_norm_pre, (bf16*)(ws + WS_XN3) + (size_t)m * DM, lane);
    }
    SEAM(9);
    PH_BEGIN(10)
        pg8::Gemm g{(const bf16*)(ws + WS_XN3), (const bf16*)(ws + WS_WG), M_TOK, DM, DM, DM, DM}; pg8::StaticOrder S; S.init(M_TOK, DM, G, bx);
        pg8::EpiGateBf E{(bf16*)(ws + WS_GE), DM};
        pg8::gemm_phase<pg8::EpiGateBf, pg8::StaticOrder, true, true>(lds, g, S, E);
    }
    SEAM(10);
    PH_BEGIN(11)
        for (int m = gw; m < M_TOK; m += NGW)
            residual_row<false>((const bf16*)(ws + WS_GE) + (size_t)m * DM, a.ple_norm_post, a.out + (size_t)m * DM, a.out + (size_t)m * DM, nullptr, nullptr, lane);
    }
#undef IN
#undef SEAM
}

#ifndef MK_PER_PHASE
#define MK_PER_PHASE 0
#endif
extern "C" void kernel_launch(void* const* d_in, const int* in_sizes, int n_in, void* d_out, int out_size, void* d_ws, size_t ws_size, hipStream_t stream) {
    static int grid = 0;
    if (grid == 0) {
        if (n_in != 26 || in_sizes[0] != M_TOK * DM || out_size != M_TOK * DM || ws_size < WS_END) { fprintf(stderr, "kernel_launch: unexpected shapes / workspace (n_in %d, ws %zu)\n", n_in, ws_size); grid = -1; return; }
        int dev = 0, cus = 0, per_cu = 0;
        if (hipGetDevice(&dev) != hipSuccess || hipDeviceGetAttribute(&cus, hipDeviceAttributeMultiprocessorCount, dev) != hipSuccess) { grid = -1; return; }
        if (hipFuncSetAttribute((const void*)fwd_megakernel, hipFuncAttributeMaxDynamicSharedMemorySize, LDS_BYTES) != hipSuccess) { fprintf(stderr, "kernel_launch: hipFuncSetAttribute failed\n"); grid = -1; return; }
        if (hipOccupancyMaxActiveBlocksPerMultiprocessor(&per_cu, (const void*)fwd_megakernel, NTHREADS, LDS_BYTES) != hipSuccess || per_cu < 1) { fprintf(stderr, "kernel_launch: occupancy query says %d blocks per CU\n", per_cu); (void)hipGetLastError(); grid = -1; return; }
        grid = cus;
    }
    if (grid < 0) return;
    Args a{};
    const float** ap = (const float**)&a;
    for (int i = 0; i < 26; ++i) ap[i] = (const float*)d_in[i];
    a.out = (float*)d_out; a.ws = (unsigned char*)d_ws;
#if MK_PER_PHASE
    for (int ph = 0; ph < N_PHASES; ++ph) { a.ph_lo = ph; a.ph_hi = ph + 1; hipLaunchKernelGGL(fwd_megakernel, dim3(grid), dim3(NTHREADS), LDS_BYTES, stream, a); }
#else
    if (hipMemsetAsync(d_ws, 0, 65536, stream) != hipSuccess) { fprintf(stderr, "kernel_launch: memset failed\n"); return; }
    a.ph_lo = 0; a.ph_hi = N_PHASES;
    void* kargs[] = {&a};
    hipError_t e = hipLaunchCooperativeKernel((const void*)fwd_megakernel, dim3(grid), dim3(NTHREADS), kargs, LDS_BYTES, stream);
    if (e != hipSuccess) fprintf(stderr, "kernel_launch: cooperative launch failed: %s (grid %d)\n", hipGetErrorString(e), grid);
#endif
}
```

```cpp
#include <hip/hip_runtime.h>
#include <hip/hip_cooperative_groups.h>
#include <cstdio>
#include <cstdint>
namespace cg = cooperative_groups;
namespace pg8 {
#define PG8_LAS __attribute__((address_space(3)))
typedef unsigned short bf16_t;
typedef short bf16x8 __attribute__((ext_vector_type(8)));
typedef float f32x4 __attribute__((ext_vector_type(4)));
typedef unsigned u32x4 __attribute__((ext_vector_type(4)));
constexpr int BM = 256, BK = 64, HALF = 128, HTB = HALF * BK * 2  , STAGE_BYTES = 8 * HTB, NXCD = 8, WGM = 8;

__host__ __device__ __forceinline__ int lds_byte(int r, int c) { const int st = (r >> 4) * 2 + (c >> 5), rr = r & 15, cc = c & 31, ob = rr * 64 + cc * 2; return st * 1024 + (ob ^ (((ob >> 9) & 1) << 5)); }
__host__ __device__ __forceinline__ void stage_rc(int b, int& R, int& C) { const int st = b / 1024, sb = b % 1024, swz = sb ^ (((sb >> 9) & 1) << 5); R = (st >> 1) * 16 + swz / 64; C = (st & 1) * 32 + (swz % 64) / 2; }
__host__ __device__ __forceinline__ int perm32(int rho) { const int n = rho >> 4, i = rho & 15; return 8 * (i >> 2) + 4 * n + (i & 3); }

struct Unit { int pm, pn; };
struct Gemm { const bf16_t* A; const bf16_t* Bt; int M, N, K, lda, ldb; };

struct StaticOrder {
    int nM, nN, nwg, G, c;
    __host__ __device__ void init(int M, int N, int G_, int c_) { nM = M / BM; nN = N / BM; nwg = nM * nN; G = G_; c = c_; }
    __host__ __device__ bool next(int i, Unit& u) const {
        const long L = (long)i * G + c; if (L >= nwg) return false;
        int wgid = (int)L; { const int q = nwg / NXCD, r = nwg % NXCD, xcd = wgid % NXCD, off = wgid / NXCD; wgid = (xcd < r ? xcd * (q + 1) : r * (q + 1) + (xcd - r) * q) + off; }
        const int nig = WGM * nN, gid = wgid / nig, fm = gid * WGM, gsz = (nM - fm) < WGM ? (nM - fm) : WGM;
        u.pm = fm + ((wgid % nig) % gsz); u.pn = (wgid % nig) / gsz; return true;
    }
    __device__ __forceinline__ void a_ready(const Unit&) const {}
    __device__ __forceinline__ void done(const Unit&) const {}
};

struct GroupOrder {
    int nj, total, G, c;
    __device__ __forceinline__ bool next(int i, Unit& u) const { const int id = i * G + c; if (id >= total) return false; const int g = id / nj; u.pm = g; u.pn = g * nj + (id - g * nj); return true; }
    __device__ __forceinline__ void a_ready(const Unit&) const {}
    __device__ __forceinline__ void done(const Unit&) const {}
};

struct StateOrder { int ng, G, c;
    __device__ __forceinline__ bool next(int i, Unit& u) const { const int g = c + i * G; if (g >= ng) return false; u.pm = g; u.pn = g; return true; }
    __device__ __forceinline__ void a_ready(const Unit&) const {}
    __device__ __forceinline__ void done(const Unit&) const {} };
struct OutOrder { int ng, G, c;
    __device__ __forceinline__ bool next(int i, Unit& u) const { const int id = c + i * G; if (id >= 2 * ng) return false; u.pm = id >> 1; u.pn = id; return true; }
    __device__ __forceinline__ void a_ready(const Unit&) const {}
    __device__ __forceinline__ void done(const Unit&) const {} };
__device__ __forceinline__ unsigned f2bf(float f) { unsigned u = __builtin_bit_cast(unsigned, f); return (u + 0x7fffu + ((u >> 16) & 1u)) >> 16; }
__device__ __forceinline__ unsigned pk2(float lo, float hi) { return f2bf(lo) | (f2bf(hi) << 16); }
__device__ __forceinline__ float bflo(unsigned w) { return __builtin_bit_cast(float, w << 16); }
__device__ __forceinline__ float bfhi(unsigned w) { return __builtin_bit_cast(float, w & 0xffff0000u); }
__device__ __forceinline__ u32x4 pack8(const f32x4& v0, const f32x4& v1) { u32x4 w; w.x = pk2(v0[0], v0[1]); w.y = pk2(v0[2], v0[3]); w.z = pk2(v1[0], v1[1]); w.w = pk2(v1[2], v1[3]); return w; }
__device__ __forceinline__ float sigmoidf_(float x) { return __builtin_amdgcn_rcpf(1.0f + __expf(-x)); }
__device__ __forceinline__ float gelu_tanh(float x) { const float z = 0.7978845608028654f * (x + 0.044715f * x * x * x); return x * __builtin_amdgcn_rcpf(1.0f + __expf(-2.0f * z)); }

struct EpiProj {
    static constexpr bool PERM = true, AFTER_DRAIN = false;
    bf16_t* Q; size_t split_stride; bf16_t* UG; float qscale;
    __device__ __forceinline__ void operator()(const f32x4 (&acc)[2][2][4][2], const Unit& u, int wr, int wc, int fr, int fq) const {
        const int row0 = u.pm * BM + wr * 64 + fr; const int t = u.pn >> 2; const int colt = (u.pn & 3) * BM + wc * 32 + 8 * fq;
        const float sc = 1.f + (t == 0 ? 1.f : 0.f) * (qscale - 1.f);
        bf16_t* base = Q + (size_t)(t < 3 ? t : 0) * split_stride;
#pragma unroll
        for (int ai = 0; ai < 2; ++ai)
#pragma unroll
            for (int m = 0; m < 4; ++m) { const int row = row0 + ai * HALF + m * 16;
#pragma unroll
                for (int bj = 0; bj < 2; ++bj) { const f32x4 v0 = acc[ai][bj][m][0] * sc, v1 = acc[ai][bj][m][1] * sc; const u32x4 w = pack8(v0, v1); const int col = colt + bj * HALF;
                    if (t < 3) *(u32x4*)(base + (size_t)row * 1024 + col) = w;
                    else { const int g = col >> 4, c = col & 15, cr = row >> 5, tt = row & 31; *(u32x4*)(UG + ((size_t)(g * 256 + cr)) * 640 + tt * 16 + c) = w; } } }
    }
};
struct EpiE {
    static constexpr bool PERM = false, AFTER_DRAIN = false;
    float* E;
    __device__ __forceinline__ void operator()(const f32x4 (&acc)[2][2][4][2], const Unit& u, int wr, int wc, int fr, int fq) const {
#pragma unroll
        for (int ai = 0; ai < 2; ++ai)
#pragma unroll
            for (int m = 0; m < 4; ++m) { const int r = ai * HALF + wr * 64 + m * 16 + fr;
#pragma unroll
                for (int n = 0; n < 2; ++n) *(f32x4*)(E + ((size_t)(u.pm * 256 + r)) * 128 + wc * 32 + 16 * n + 4 * fq) = acc[ai][0][m][n]; }
    }
};
struct EpiY {
    static constexpr bool PERM = true, AFTER_DRAIN = false;
    const bf16_t* UG; const float* Dskip; bf16_t* YB;
    __device__ __forceinline__ void operator()(const f32x4 (&acc)[2][2][4][2], const Unit& u, int wr, int wc, int fr, int fq) const {
        const int g = u.pm, j = u.pn - 2 * g;
#pragma unroll
        for (int bj = 0; bj < 2; ++bj) { const int cgc = j * 256 + bj * HALF + wc * 32 + 8 * fq; const int t = cgc >> 4, c = cgc & 15, ch = g * 16 + c;
            const f32x4 d0 = *(const f32x4*)(Dskip + ch), d1 = *(const f32x4*)(Dskip + ch + 4);
#pragma unroll
            for (int ai = 0; ai < 2; ++ai)
#pragma unroll
                for (int m = 0; m < 4; ++m) { const int r = ai * HALF + wr * 64 + m * 16 + fr;
                    const u32x4 uw = *(const u32x4*)(UG + ((size_t)(g * 256 + r)) * 640 + cgc);
                    f32x4 v0 = acc[ai][bj][m][0], v1 = acc[ai][bj][m][1];
                    v0[0] += d0[0] * bflo(uw.x); v0[1] += d0[1] * bfhi(uw.x); v0[2] += d0[2] * bflo(uw.y); v0[3] += d0[3] * bfhi(uw.y);
                    v1[0] += d1[0] * bflo(uw.z); v1[1] += d1[1] * bfhi(uw.z); v1[2] += d1[2] * bflo(uw.w); v1[3] += d1[3] * bfhi(uw.w);
#pragma unroll
                    for (int e = 0; e < 4; ++e) { v0[e] = gelu_tanh(v0[e]); v1[e] = gelu_tanh(v1[e]); }
                    *(u32x4*)(YB + ((size_t)(r * 32 + t)) * 1024 + ch) = pack8(v0, v1); } }
    }
};
struct EpiGLU {
    static constexpr bool PERM = true, AFTER_DRAIN = false;
    const bf16_t* YB; const float* bias; bf16_t* O;
    __device__ __forceinline__ void operator()(const f32x4 (&acc)[2][2][4][2], const Unit& u, int wr, int wc, int fr, int fq) const {
        const int row0 = u.pm * BM + wr * 64 + fr;
#pragma unroll
        for (int bj = 0; bj < 2; ++bj) { const int col = u.pn * BM + bj * HALF + wc * 32 + 8 * fq;
            const f32x4 b0 = *(const f32x4*)(bias + col), b1 = *(const f32x4*)(bias + col + 4);
#pragma unroll
            for (int ai = 0; ai < 2; ++ai)
#pragma unroll
                for (int m = 0; m < 4; ++m) { const size_t off = (size_t)(row0 + ai * HALF + m * 16) * 1024 + col;
                    const u32x4 yw = *(const u32x4*)(YB + off);
                    f32x4 v0 = acc[ai][bj][m][0] + b0, v1 = acc[ai][bj][m][1] + b1;
                    v0[0] = bflo(yw.x) * sigmoidf_(v0[0]); v0[1] = bfhi(yw.x) * sigmoidf_(v0[1]); v0[2] = bflo(yw.y) * sigmoidf_(v0[2]); v0[3] = bfhi(yw.y) * sigmoidf_(v0[3]);
                    v1[0] = bflo(yw.z) * sigmoidf_(v1[0]); v1[1] = bfhi(yw.z) * sigmoidf_(v1[1]); v1[2] = bflo(yw.w) * sigmoidf_(v1[2]); v1[3] = bfhi(yw.w) * sigmoidf_(v1[3]);
                    *(u32x4*)(O + off) = pack8(v0, v1); } }
    }
};
struct EpiF32 {
    static constexpr bool PERM = false, AFTER_DRAIN = false;
    float* O; int ldc;
    __device__ __forceinline__ void operator()(const f32x4 (&acc)[2][2][4][2], const Unit& u, int wr, int wc, int fr, int fq) const {
        const int row0 = u.pm * BM + wr * 64 + fr, col0 = u.pn * BM + wc * 32 + 4 * fq;
#pragma unroll
        for (int ai = 0; ai < 2; ++ai)
#pragma unroll
            for (int m = 0; m < 4; ++m) { float* rowp = O + (size_t)(row0 + ai * HALF + m * 16) * ldc + col0;
#pragma unroll
                for (int bj = 0; bj < 2; ++bj)
#pragma unroll
                    for (int n = 0; n < 2; ++n) *(f32x4*)(rowp + bj * HALF + n * 16) = acc[ai][bj][m][n]; }
    }
};
struct EpiBf16Plain {
    static constexpr bool PERM = true, AFTER_DRAIN = false;
    bf16_t* O; int ldc;
    __device__ __forceinline__ void operator()(const f32x4 (&acc)[2][2][4][2], const Unit& u, int wr, int wc, int fr, int fq) const {
        const int row0 = u.pm * BM + wr * 64 + fr, col0 = u.pn * BM + wc * 32 + 8 * fq;
#pragma unroll
        for (int ai = 0; ai < 2; ++ai)
#pragma unroll
            for (int m = 0; m < 4; ++m) { bf16_t* rowp = O + (size_t)(row0 + ai * HALF + m * 16) * ldc + col0;
#pragma unroll
                for (int bj = 0; bj < 2; ++bj) *(u32x4*)(rowp + bj * HALF) = pack8(acc[ai][bj][m][0], acc[ai][bj][m][1]); }
    }
};
struct EpiGateBf {
    static constexpr bool PERM = true, AFTER_DRAIN = false;
    bf16_t* GE; int ldc;
    __device__ __forceinline__ void operator()(const f32x4 (&acc)[2][2][4][2], const Unit& u, int wr, int wc, int fr, int fq) const {
        const int row0 = u.pm * BM + wr * 64 + fr, col0 = u.pn * BM + wc * 32 + 8 * fq;
#pragma unroll
        for (int ai = 0; ai < 2; ++ai)
#pragma unroll
            for (int m = 0; m < 4; ++m) { bf16_t* rowp = GE + (size_t)(row0 + ai * HALF + m * 16) * ldc + col0;
#pragma unroll
                for (int bj = 0; bj < 2; ++bj) { const u32x4 ew = *(const u32x4*)(rowp + bj * HALF); f32x4 v0 = acc[ai][bj][m][0], v1 = acc[ai][bj][m][1];
                    v0[0] = bflo(ew.x) * sigmoidf_(v0[0]); v0[1] = bfhi(ew.x) * sigmoidf_(v0[1]); v0[2] = bflo(ew.y) * sigmoidf_(v0[2]); v0[3] = bfhi(ew.y) * sigmoidf_(v0[3]);
                    v1[0] = bflo(ew.z) * sigmoidf_(v1[0]); v1[1] = bfhi(ew.z) * sigmoidf_(v1[1]); v1[2] = bflo(ew.w) * sigmoidf_(v1[2]); v1[3] = bfhi(ew.w) * sigmoidf_(v1[3]);
                    *(u32x4*)(rowp + bj * HALF) = pack8(v0, v1); } }
    }
};
struct EpiRelu2 {
    static constexpr bool PERM = true, AFTER_DRAIN = false;
    bf16_t* O; int ldc;
    __device__ __forceinline__ void operator()(const f32x4 (&acc)[2][2][4][2], const Unit& u, int wr, int wc, int fr, int fq) const {
        const int row0 = u.pm * BM + wr * 64 + fr, col0 = u.pn * BM + wc * 32 + 8 * fq;
#pragma unroll
        for (int ai = 0; ai < 2; ++ai)
#pragma unroll
            for (int m = 0; m < 4; ++m) { bf16_t* rowp = O + (size_t)(row0 + ai * HALF + m * 16) * ldc + col0;
#pragma unroll
                for (int bj = 0; bj < 2; ++bj) { f32x4 v0 = acc[ai][bj][m][0], v1 = acc[ai][bj][m][1];
#pragma unroll
                    for (int e = 0; e < 4; ++e) { const float a = fmaxf(v0[e], 0.f), b = fmaxf(v1[e], 0.f); v0[e] = a * a; v1[e] = b * b; }
                    *(u32x4*)(rowp + bj * HALF) = pack8(v0, v1); } }
    }
};
struct EpiGate {
    static constexpr bool PERM = false, AFTER_DRAIN = false;
    float* GE; int ldc;
    __device__ __forceinline__ void operator()(const f32x4 (&acc)[2][2][4][2], const Unit& u, int wr, int wc, int fr, int fq) const {
        const int row0 = u.pm * BM + wr * 64 + fr, col0 = u.pn * BM + wc * 32 + 4 * fq;
#pragma unroll
        for (int ai = 0; ai < 2; ++ai)
#pragma unroll
            for (int m = 0; m < 4; ++m) { float* rowp = GE + (size_t)(row0 + ai * HALF + m * 16) * ldc + col0;
#pragma unroll
                for (int bj = 0; bj < 2; ++bj)
#pragma unroll
                    for (int n = 0; n < 2; ++n) { const f32x4 e = *(const f32x4*)(rowp + bj * HALF + n * 16); const f32x4 a = acc[ai][bj][m][n]; f32x4 o;
#pragma unroll
                        for (int q = 0; q < 4; ++q) o[q] = e[q] * sigmoidf_(a[q]);
                        *(f32x4*)(rowp + bj * HALF + n * 16) = o; } }
    }
};

template <class Epi, class Sched, bool ALIGN_EPI = false, bool SP2 = false>
__device__ __forceinline__ void gemm_phase(PG8_LAS unsigned char* lds, const Gemm g, const Sched& S, const Epi& E) {
    const int tid = threadIdx.x, wid = __builtin_amdgcn_readfirstlane(tid >> 6), lane = tid & 63, wr = wid >> 2, wc = wid & 3, fr = lane & 15, fq = lane >> 4;
    const int K = g.K, nt = K / BK;
    unsigned voffA[2], voffB[2];
#pragma unroll
    for (int i = 0; i < 2; ++i) { int R, C; stage_rc(tid * 16 + i * 8192, R, C); const int Rb = Epi::PERM ? ((R & ~31) + perm32(R & 31)) : R;
        voffA[i] = (unsigned)(R * g.lda + C) * 2u; voffB[i] = (unsigned)(Rb * g.ldb + C) * 2u; }
    const size_t kstep = (size_t)(BK * 2);
    const size_t hstepA = (size_t)HALF * g.lda * 2, hstepB = (size_t)HALF * g.ldb * 2;
    const size_t tstepA = 2 * hstepA, tstepB = 2 * hstepB;
    const unsigned ldsw = (unsigned)wid * 1024u;
    const int aoff = lds_byte(wr * 64 + fr, fq * 8), boff = lds_byte(wc * 32 + fr, fq * 8);
#define PG8_SA(b, h) (((b) * 2 + (h)) * HTB)
#define PG8_SB(b, h) ((4 + (b) * 2 + (h)) * HTB)
#define PG8_STAGE(bufoff, gbase, voff) do { _Pragma("unroll") for (int _i = 0; _i < 2; ++_i) \
        __builtin_amdgcn_global_load_lds((const unsigned*)((const char*)(gbase) + (voff)[_i]), (PG8_LAS unsigned*)(lds + (bufoff) + ldsw + _i * 8192), 16, 0, 0); } while (0)
#define PG8_LDA(dst, b, h) do { _Pragma("unroll") for (int m = 0; m < 4; ++m) _Pragma("unroll") for (int k = 0; k < 2; ++k) dst[m][k] = *(const PG8_LAS bf16x8*)(lds + PG8_SA(b, h) + aoff + m * 2048 + k * 1024); } while (0)
#define PG8_LDB(dst, b, h) do { _Pragma("unroll") for (int n = 0; n < 2; ++n) _Pragma("unroll") for (int k = 0; k < 2; ++k) dst[n][k] = *(const PG8_LAS bf16x8*)(lds + PG8_SB(b, h) + boff + n * 2048 + k * 1024); } while (0)
#define PG8_MMA(ai, bj, At, Bt) do { __builtin_amdgcn_s_setprio(1); _Pragma("unroll") for (int m = 0; m < 4; ++m) _Pragma("unroll") for (int n = 0; n < 2; ++n) _Pragma("unroll") for (int k = 0; k < 2; ++k) \
        acc[ai][bj][m][n] = __builtin_amdgcn_mfma_f32_16x16x32_bf16(Bt[n][k], At[m][k], acc[ai][bj][m][n], 0, 0, 0); __builtin_amdgcn_s_setprio(0); } while (0)
#define PG8_WAIT_V(n) asm volatile("s_waitcnt vmcnt(" #n ")" ::: "memory")
#define PG8_WAIT_L(n) asm volatile("s_waitcnt lgkmcnt(" #n ")" ::: "memory")
#define PG8_BAR __builtin_amdgcn_s_barrier()
#define PG8_SCHED __builtin_amdgcn_sched_barrier(0)
    Unit cur, nxt; int ui = 0;
    if (!S.next(0, cur)) return;
    f32x4 acc[2][2][4][2];
#pragma unroll
    for (int a = 0; a < 2; ++a)
#pragma unroll
        for (int b = 0; b < 2; ++b)
#pragma unroll
            for (int m = 0; m < 4; ++m)
#pragma unroll
                for (int n = 0; n < 2; ++n) acc[a][b][m][n] = (f32x4){0.f, 0.f, 0.f, 0.f};
    bf16x8 At[4][2], B0[2][2], B1[2][2];
    const char* cA = (const char*)g.A + (size_t)cur.pm * tstepA; const char* cB = (const char*)g.Bt + (size_t)cur.pn * tstepB;
    S.a_ready(cur);
    if constexpr (SP2) {
        PG8_STAGE(PG8_SB(0, 0), cB, voffB); PG8_STAGE(PG8_SB(0, 1), cB + hstepB, voffB); PG8_STAGE(PG8_SA(0, 0), cA, voffA); PG8_STAGE(PG8_SA(0, 1), cA + hstepA, voffA);
        if (wr == 1) PG8_BAR;
        PG8_WAIT_V(2); PG8_BAR;
        PG8_STAGE(PG8_SB(1, 0), cB + kstep, voffB); PG8_STAGE(PG8_SA(1, 0), cA + kstep, voffA); PG8_STAGE(PG8_SB(1, 1), cB + hstepB + kstep, voffB);
        PG8_WAIT_V(6); PG8_BAR;
    } else {
        PG8_STAGE(PG8_SB(0, 0), cB, voffB); PG8_STAGE(PG8_SA(0, 0), cA, voffA); PG8_STAGE(PG8_SB(0, 1), cB + hstepB, voffB); PG8_STAGE(PG8_SA(0, 1), cA + hstepA, voffA);
        if (wr == 1) PG8_BAR;
        PG8_WAIT_V(4); PG8_BAR;
        PG8_STAGE(PG8_SB(1, 0), cB + kstep, voffB); PG8_STAGE(PG8_SA(1, 0), cA + kstep, voffA); PG8_STAGE(PG8_SB(1, 1), cB + hstepB + kstep, voffB);
        PG8_WAIT_V(6); PG8_BAR;
    }
    for (;;) {
        const bool has_next = S.next(ui + 1, nxt);
        const char* nA = has_next ? (const char*)g.A + (size_t)nxt.pm * tstepA : cA; const char* nB = has_next ? (const char*)g.Bt + (size_t)nxt.pn * tstepB : cB;
        for (int t = 0; t < nt; t += 2) {
            const bool last = (t == nt - 2);
            const char* a1 = cA + (size_t)(t + 1) * kstep;
            const char* a2 = last ? nA : cA + (size_t)(t + 2) * kstep; const char* b2 = last ? nB : cB + (size_t)(t + 2) * kstep;
            const char* a3 = a2 + kstep; const char* b3 = b2 + kstep;
            if (last && has_next) S.a_ready(nxt);
            if constexpr (SP2) {
            PG8_LDB(B0, 0, 0); PG8_LDB(B1, 0, 1); PG8_SCHED; PG8_LDA(At, 0, 0); PG8_STAGE(PG8_SA(1, 1), a1 + hstepA, voffA);
            PG8_WAIT_V(8); PG8_WAIT_L(0); PG8_BAR; PG8_MMA(0, 0, At, B0); PG8_MMA(0, 1, At, B1); PG8_BAR; PG8_SCHED;
            PG8_LDA(At, 0, 1); PG8_STAGE(PG8_SB(0, 0), b2, voffB); PG8_STAGE(PG8_SB(0, 1), b2 + hstepB, voffB); PG8_STAGE(PG8_SA(0, 0), a2, voffA);
            PG8_WAIT_V(8); PG8_WAIT_L(0); PG8_BAR; PG8_MMA(1, 0, At, B0); PG8_MMA(1, 1, At, B1); PG8_BAR; PG8_SCHED;
            PG8_LDB(B0, 1, 0); PG8_LDB(B1, 1, 1); PG8_SCHED; PG8_LDA(At, 1, 0); PG8_STAGE(PG8_SA(0, 1), a2 + hstepA, voffA);
            PG8_WAIT_V(8); PG8_WAIT_L(0); PG8_BAR; PG8_MMA(0, 0, At, B0); PG8_MMA(0, 1, At, B1); PG8_BAR; PG8_SCHED;
            PG8_LDA(At, 1, 1); PG8_STAGE(PG8_SB(1, 0), b3, voffB); PG8_STAGE(PG8_SB(1, 1), b3 + hstepB, voffB); PG8_STAGE(PG8_SA(1, 0), a3, voffA);
            PG8_WAIT_V(8); PG8_WAIT_L(0); PG8_BAR; PG8_MMA(1, 0, At, B0); PG8_MMA(1, 1, At, B1); PG8_BAR; PG8_SCHED;
            } else {
            PG8_LDB(B0, 0, 0); PG8_SCHED; PG8_LDA(At, 0, 0); PG8_STAGE(PG8_SA(1, 1), a1 + hstepA, voffA);
            PG8_WAIT_L(8); PG8_BAR; PG8_WAIT_L(0); PG8_MMA(0, 0, At, B0); PG8_BAR; PG8_SCHED;
            PG8_LDB(B1, 0, 1); PG8_STAGE(PG8_SB(0, 0), b2, voffB);
            PG8_BAR; PG8_WAIT_L(0); PG8_MMA(0, 1, At, B1); PG8_BAR;
            PG8_LDA(At, 0, 1); PG8_STAGE(PG8_SA(0, 0), a2, voffA);
            PG8_BAR; PG8_WAIT_L(0); PG8_MMA(1, 0, At, B0); PG8_BAR; PG8_SCHED;
            PG8_STAGE(PG8_SB(0, 1), b2 + hstepB, voffB);
            PG8_WAIT_V(6); PG8_BAR; PG8_MMA(1, 1, At, B1); PG8_BAR;
            PG8_LDB(B0, 1, 0); PG8_SCHED; PG8_LDA(At, 1, 0); PG8_STAGE(PG8_SA(0, 1), a2 + hstepA, voffA);
            PG8_WAIT_L(8); PG8_BAR; PG8_WAIT_L(0); PG8_MMA(0, 0, At, B0); PG8_BAR; PG8_SCHED;
            PG8_LDB(B1, 1, 1); PG8_STAGE(PG8_SB(1, 0), b3, voffB);
            PG8_BAR; PG8_WAIT_L(0); PG8_MMA(0, 1, At, B1); PG8_BAR;
            PG8_LDA(At, 1, 1); PG8_STAGE(PG8_SA(1, 0), a3, voffA);
            PG8_BAR; PG8_WAIT_L(0); PG8_MMA(1, 0, At, B0); PG8_BAR; PG8_SCHED;
            PG8_STAGE(PG8_SB(1, 1), b3 + hstepB, voffB);
            PG8_WAIT_V(6); PG8_BAR; PG8_MMA(1, 1, At, B1); PG8_BAR;
            }
        }
        if constexpr (ALIGN_EPI) { if (wr == 0) PG8_BAR; }
        if constexpr (!Epi::AFTER_DRAIN) { E(acc, cur, wr, wc, fr, fq); S.done(cur); }
        if (!has_next) break;
#pragma unroll
        for (int a = 0; a < 2; ++a)
#pragma unroll
            for (int b = 0; b < 2; ++b)
#pragma unroll
                for (int m = 0; m < 4; ++m)
#pragma unroll
                    for (int n = 0; n < 2; ++n) acc[a][b][m][n] = (f32x4){0.f, 0.f, 0.f, 0.f};
        cur = nxt; cA = nA; cB = nB; ++ui;
        if constexpr (ALIGN_EPI) { if (wr == 1) PG8_BAR; }
    }
    PG8_WAIT_V(0);
    if constexpr (!ALIGN_EPI) { if (wr == 0) PG8_BAR; }
    PG8_BAR;
    if constexpr (Epi::AFTER_DRAIN) { E.fused(acc, cur, wr, wc, fr, fq, lds, wid, lane); S.done(cur); }
#undef PG8_SA
#undef PG8_SB
#undef PG8_STAGE
#undef PG8_LDA
#undef PG8_LDB
#undef PG8_MMA
#undef PG8_WAIT_V
#undef PG8_WAIT_L
#undef PG8_BAR
#undef PG8_SCHED
}
}

constexpr int NWAVES = 8, NTHREADS = 512;
constexpr int M_TOK = 8192, SEQ = 4096, DM = 2048, NPROJ = 4096, AW = 1024, NH = 8, DFF = 8192, PLE = 256;
constexpr int SG = 64, SP = 64, SC = 16, CHL = 32, UGK = 640;
constexpr float RMS_EPS = 1e-6f;
constexpr float QSCALE = 0.08838834764831845f * 1.4426950408889634f;

constexpr size_t MiB = 1u << 20;
constexpr size_t WS_XN = 1 * MiB;
constexpr size_t WS_WIN = 33 * MiB, WS_WGLU = 49 * MiB, WS_WOUT = 51 * MiB;
constexpr size_t WS_Q = 59 * MiB, WS_K = 75 * MiB, WS_V = 91 * MiB;
constexpr size_t WS_SSMO = WS_K, WS_YB = WS_WIN;
constexpr size_t WS_UG = 107 * MiB, WS_E = 127 * MiB, WS_HST = 135 * MiB, WS_BSB = 151 * MiB;
constexpr size_t WS_OB = 191 * MiB, WS_LSE = 239 * MiB, WS_PW = 240 * MiB, WS_BBAR = 242 * MiB, WS_KT = 243 * MiB;
constexpr size_t WS_MIX = 123 * MiB;
constexpr size_t WS_WUP = 33 * MiB, WS_WDOWN = 65 * MiB, WS_WG = 97 * MiB, WS_WP = 105 * MiB, WS_PB = 106 * MiB;
constexpr size_t WS_HID = 123 * MiB;
constexpr size_t WS_FF = 1 * MiB;
constexpr size_t WS_XN3 = 123 * MiB, WS_GE = 155 * MiB;
constexpr size_t WS_END = 251 * MiB;
constexpr size_t OB_STRIDE = (size_t)M_TOK * AW;

constexpr int LDS_BYTES = 147456;
#define LAS __attribute__((address_space(3)))
typedef unsigned short bf16;
typedef unsigned v4u __attribute__((ext_vector_type(4)));
typedef unsigned v2u __attribute__((ext_vector_type(2)));
typedef float f32x4 __attribute__((ext_vector_type(4)));
typedef float f32x2 __attribute__((ext_vector_type(2)));
typedef float f32x16 __attribute__((ext_vector_type(16)));
typedef short bf16x8 __attribute__((ext_vector_type(8)));
using pg8::f2bf; using pg8::pk2; using pg8::bflo; using pg8::bfhi;
#define LDS_WAIT() asm volatile("s_waitcnt lgkmcnt(0)" ::: "memory")

__device__ __forceinline__ float wave_sum(float v) {
#pragma unroll
    for (int o = 1; o < 64; o <<= 1) v += __shfl_xor(v, o);
    return v;
}
__device__ __forceinline__ void transpose_item(const float* W, int K, int N, bf16* WT, LAS float* scr, int item, int lane) {
    const int nblk = N / 32, kb = item / nblk, nb = item % nblk, k0 = 64 * kb, n0 = 32 * nb;
    { f32x4 t4[8];
#pragma unroll
      for (int i = 0; i < 8; ++i) t4[i] = *(const f32x4*)(W + (size_t)(k0 + 8 * i + (lane >> 3)) * N + n0 + 4 * (lane & 7));
#pragma unroll
      for (int i = 0; i < 8; ++i) { LAS float* d = scr + (8 * i + (lane >> 3)) * 33 + 4 * (lane & 7); d[0] = t4[i].x; d[1] = t4[i].y; d[2] = t4[i].z; d[3] = t4[i].w; } }
    LDS_WAIT();
    const int c = lane & 7;
#pragma unroll
    for (int j = 0; j < 4; ++j) { const int n = (lane >> 3) + 8 * j; const LAS float* s = scr + (8 * c) * 33 + n;
        v4u o; o.x = pk2(s[0 * 33], s[1 * 33]); o.y = pk2(s[2 * 33], s[3 * 33]); o.z = pk2(s[4 * 33], s[5 * 33]); o.w = pk2(s[6 * 33], s[7 * 33]);
        *(v4u*)(WT + (size_t)(n0 + n) * K + k0 + 8 * c) = o; }
    LDS_WAIT();
}
__device__ __forceinline__ void rms_row_to_bf16(const float* xrow, const float* gain, bf16* orow, int lane) {
    const f32x4* xr = (const f32x4*)xrow + lane; const f32x4* gr = (const f32x4*)gain + lane;
    f32x4 v[8]; float s = 0.f;
#pragma unroll
    for (int j = 0; j < 8; ++j) { v[j] = xr[64 * j]; s += (v[j].x * v[j].x + v[j].y * v[j].y) + (v[j].z * v[j].z + v[j].w * v[j].w); }
    const float rs = 1.0f / sqrtf(wave_sum(s) * (1.0f / DM) + RMS_EPS);
    v2u* o8 = (v2u*)orow + lane;
#pragma unroll
    for (int j = 0; j < 8; ++j) { const f32x4 g = gr[64 * j]; v2u w; w.x = pk2(v[j].x * rs * g.x, v[j].y * rs * g.y); w.y = pk2(v[j].z * rs * g.z, v[j].w * rs * g.w); o8[64 * j] = w; }
}
template <bool WITH_XN>
__device__ __forceinline__ void residual_row(const bf16* yrow, const float* g1, const float* hbase, float* hout, const float* g2, bf16* xnrow, int lane) {
    float v[32]; float s = 0.f;
#pragma unroll
    for (int j = 0; j < 4; ++j) { const v4u w = *((const v4u*)yrow + lane + 64 * j);
        v[8 * j + 0] = bflo(w.x); v[8 * j + 1] = bfhi(w.x); v[8 * j + 2] = bflo(w.y); v[8 * j + 3] = bfhi(w.y); v[8 * j + 4] = bflo(w.z); v[8 * j + 5] = bfhi(w.z); v[8 * j + 6] = bflo(w.w); v[8 * j + 7] = bfhi(w.w); }
#pragma unroll
    for (int i = 0; i < 32; ++i) s += v[i] * v[i];
    const float rs = 1.0f / sqrtf(wave_sum(s) * (1.0f / DM) + RMS_EPS);
    float s2 = 0.f;
#pragma unroll
    for (int j = 0; j < 4; ++j) { const int e0 = (lane + 64 * j) * 8;
#pragma unroll
        for (int q = 0; q < 2; ++q) { const f32x4 g = *(const f32x4*)(g1 + e0 + 4 * q); const f32x4 b = *(const f32x4*)(hbase + e0 + 4 * q); f32x4 o;
            o.x = b.x + v[8 * j + 4 * q] * rs * g.x; o.y = b.y + v[8 * j + 4 * q + 1] * rs * g.y; o.z = b.z + v[8 * j + 4 * q + 2] * rs * g.z; o.w = b.w + v[8 * j + 4 * q + 3] * rs * g.w;
            *(f32x4*)(hout + e0 + 4 * q) = o; v[8 * j + 4 * q] = o.x; v[8 * j + 4 * q + 1] = o.y; v[8 * j + 4 * q + 2] = o.z; v[8 * j + 4 * q + 3] = o.w;
            s2 += (o.x * o.x + o.y * o.y) + (o.z * o.z + o.w * o.w); } }
    if (WITH_XN) {
        const float rs2 = 1.0f / sqrtf(wave_sum(s2) * (1.0f / DM) + RMS_EPS);
#pragma unroll
        for (int j = 0; j < 4; ++j) { const int e0 = (lane + 64 * j) * 8; const f32x4 ga = *(const f32x4*)(g2 + e0), gb = *(const f32x4*)(g2 + e0 + 4);
            *((v4u*)xnrow + lane + 64 * j) = (v4u){pk2(v[8 * j] * rs2 * ga.x, v[8 * j + 1] * rs2 * ga.y), pk2(v[8 * j + 2] * rs2 * ga.z, v[8 * j + 3] * rs2 * ga.w),
                                                    pk2(v[8 * j + 4] * rs2 * gb.x, v[8 * j + 5] * rs2 * gb.y), pk2(v[8 * j + 6] * rs2 * gb.z, v[8 * j + 7] * rs2 * gb.w)}; }
    }
}
__device__ __forceinline__ void cexp_lam(double lr, double li, double dt, double& ar, double& ai) {
    const double x = lr * dt;
    double e = 1.0; { double term = 1.0; for (int k = 1; k <= 14; ++k) { term *= x / (double)k; e += term; } }
    double th = li * dt;
    const double TWO_PI_HI = 6.283185307179586, TWO_PI_LO = 2.4492935982947064e-16;
    const double kq = rint(th * 0.15915494309189535); th = (th - kq * TWO_PI_HI) - kq * TWO_PI_LO;
    const double y = th * 0.0625, y2 = y * y;
    double s = y * (1.0 - y2 / 6.0 * (1.0 - y2 / 20.0 * (1.0 - y2 / 42.0 * (1.0 - y2 / 72.0 * (1.0 - y2 / 110.0 * (1.0 - y2 / 156.0))))));
    double c = 1.0 - y2 / 2.0 * (1.0 - y2 / 12.0 * (1.0 - y2 / 30.0 * (1.0 - y2 / 56.0 * (1.0 - y2 / 90.0 * (1.0 - y2 / 132.0)))));
#pragma unroll
    for (int k = 0; k < 4; ++k) { const double s2 = 2.0 * s * c, c2 = c * c - s * s; s = s2; c = c2; }
    ar = e * c; ai = e * s;
}
__device__ __forceinline__ double exp_f64(double x) {
    const double kq = rint(x * 1.4426950408889634); const double r = (x - kq * 0.6931471803691238) - kq * 1.9082149292705877e-10;
    double e = 1.0, term = 1.0; for (int k = 1; k <= 16; ++k) { term *= r / (double)k; e += term; }
    const long long bits = (long long)(1023 + (int)kq) << 52; return e * __builtin_bit_cast(double, bits);
}

__device__ __forceinline__ int crow(int reg, int h) { return (reg & 3) + 8 * (reg >> 2) + 4 * h; }
#define MFMA32(a, b, c) __builtin_amdgcn_mfma_f32_32x32x16_bf16((a), (b), (c), 0, 0, 0)
constexpr int VROW = 272;
__device__ __forceinline__ void attn_wave_unit(int wu, const bf16* Q, const bf16* K, const bf16* V, bf16* OB, float* LSE, LAS unsigned char* vbuf, int lane) {
    const int sub = wu & 3, blk = (wu >> 2) & 31, h = (wu >> 7) & 7, b = (wu >> 10) & 1, br = wu >> 11;
    const int dsh = 2 * br, d = 1 << dsh, nbm = (32 >> dsh) - 1, r = blk >> (5 - dsh), n = blk & nbm;
    const int iq = lane & 31, hh = lane >> 5;
    const int m0 = n * 128 + sub * 32;
    const size_t tokq = (size_t)b * SEQ + (size_t)(m0 + iq) * d + r;
    const int jmin = (n == 0) ? (4 - sub) : 0;
    const bf16* kbase = K + ((size_t)b * SEQ + r) * AW + h * 128 + hh * 8;
    const bf16* vbase = V + ((size_t)b * SEQ + r) * AW + h * 128 + (lane & 15) * 8;
    const size_t rstep = (size_t)d * AW;
    bf16x8 qf[8], kf[8]; v4u vst[8];
    { const bf16* qrow = Q + tokq * AW + h * 128 + hh * 8;
#pragma unroll
      for (int kk = 0; kk < 8; ++kk) qf[kk] = *(const bf16x8*)(qrow + kk * 16); }
    { const int kb = m0 - 128 + 32 * jmin; const bf16* krow = kbase + (size_t)(kb + iq) * rstep;
#pragma unroll
      for (int kk = 0; kk < 8; ++kk) kf[kk] = *(const bf16x8*)(krow + kk * 16);
#pragma unroll
      for (int it = 0; it < 8; ++it) vst[it] = *(const v4u*)(vbase + (size_t)(kb + it * 4 + (lane >> 4)) * rstep);
#pragma unroll
      for (int it = 0; it < 8; ++it) *(LAS v4u*)(vbuf + (it * 4 + (lane >> 4)) * VROW + (lane & 15) * 16) = vst[it]; }
    f32x16 o[4];
#pragma unroll
    for (int dt = 0; dt < 4; ++dt)
#pragma unroll
        for (int i = 0; i < 16; ++i) o[dt][i] = 0.f;
    float rmax = -1e30f, rsum = 0.f;
    for (int j = jmin; j <= 4; ++j) {
        LAS unsigned char* vcur = vbuf + ((j - jmin) & 1) * (32 * VROW);
        LAS unsigned char* vnxt = vbuf + (((j - jmin) & 1) ^ 1) * (32 * VROW);
        f32x16 st;
#pragma unroll
        for (int i = 0; i < 16; ++i) st[i] = 0.f;
#pragma unroll
        for (int kk = 0; kk < 8; ++kk) st = MFMA32(kf[kk], qf[kk], st);
        if (j < 4) {
            const int kb = m0 - 128 + 32 * (j + 1); const bf16* krow = kbase + (size_t)(kb + iq) * rstep;
#pragma unroll
            for (int kk = 0; kk < 8; ++kk) kf[kk] = *(const bf16x8*)(krow + kk * 16);
#pragma unroll
            for (int it = 0; it < 8; ++it) vst[it] = *(const v4u*)(vbase + (size_t)(kb + it * 4 + (lane >> 4)) * rstep);
        }
        if (j == 0) {
#pragma unroll
            for (int i = 0; i < 16; ++i) if (crow(i, hh) < iq) st[i] = -1e30f;
        }
        if (j == 4) {
#pragma unroll
            for (int i = 0; i < 16; ++i) if (crow(i, hh) > iq) st[i] = -1e30f;
        }
        float tmax = st[0];
#pragma unroll
        for (int i = 1; i < 16; ++i) tmax = fmaxf(tmax, st[i]);
        tmax = fmaxf(tmax, __shfl_xor(tmax, 32));
        const float nmax = fmaxf(rmax, tmax);
        const float alpha = __builtin_amdgcn_exp2f(rmax - nmax);
        rmax = nmax;
        float psum = 0.f;
#pragma unroll
        for (int i = 0; i < 16; ++i) { st[i] = __builtin_amdgcn_exp2f(st[i] - nmax); psum += st[i]; }
        rsum = rsum * alpha + psum;
#pragma unroll
        for (int dt = 0; dt < 4; ++dt)
#pragma unroll
            for (int i = 0; i < 16; ++i) o[dt][i] *= alpha;
        LDS_WAIT();
#pragma unroll
        for (int s = 0; s < 2; ++s) {
            bf16x8 pf;
#pragma unroll
            for (int e = 0; e < 8; ++e) pf[e] = (short)f2bf(st[8 * s + e]);
#pragma unroll
            for (int dt = 0; dt < 4; ++dt) {
                bf16x8 vf;
#pragma unroll
                for (int e = 0; e < 8; ++e) vf[e] = *(const LAS short*)(vcur + crow(8 * s + e, hh) * VROW + (dt * 32 + iq) * 2);
                o[dt] = MFMA32(vf, pf, o[dt]);
            }
        }
        if (j < 4) {
#pragma unroll
            for (int it = 0; it < 8; ++it) *(LAS v4u*)(vnxt + (it * 4 + (lane >> 4)) * VROW + (lane & 15) * 16) = vst[it];
        }
    }
    LDS_WAIT();
    const float tot = rsum + __shfl_xor(rsum, 32);
    const float inv = 1.0f / tot;
    bf16* orow = OB + (size_t)br * OB_STRIDE + tokq * AW + h * 128 + 4 * hh;
#pragma unroll
    for (int dt = 0; dt < 4; ++dt)
#pragma unroll
        for (int gq = 0; gq < 4; ++gq) { v2u w; w.x = pk2(o[dt][4 * gq] * inv, o[dt][4 * gq + 1] * inv); w.y = pk2(o[dt][4 * gq + 2] * inv, o[dt][4 * gq + 3] * inv);
            *(v2u*)(orow + dt * 32 + 8 * gq) = w; }
    if (hh == 0) LSE[((size_t)br * M_TOK + tokq) * NH + h] = rmax + __log2f(tot);
}

#define XB_TMO      128
#define XB_XCNT(j)  (256  + 64 * (j))
#define XB_XSUB(j)  (1280 + 64 * (j))
#define XB_XGEN(j)  (2304 + 64 * (j))
#define XB_TOP      3328
#define XB_TOPGEN   3392
#define XCD_BAR_WORDS 3456
#define XB_SPIN_CAP (1u << 18)

__device__ __forceinline__ unsigned xb_ld(unsigned* p)              { return __hip_atomic_load(p, __ATOMIC_RELAXED, __HIP_MEMORY_SCOPE_AGENT); }
__device__ __forceinline__ unsigned xb_add(unsigned* p, unsigned v) { return __hip_atomic_fetch_add(p, v, __ATOMIC_RELAXED, __HIP_MEMORY_SCOPE_AGENT); }
__device__ __forceinline__ unsigned xb_xcc_id() { return (unsigned)__builtin_amdgcn_s_getreg((3 << 11) | 20) & 0xFu; }
#define XB_SPIN(cond, bar) do { unsigned _sp = 0; while (cond) { __builtin_amdgcn_s_sleep(1); \
    if ((++_sp & 255u) == 0u) { if (xb_ld(&(bar)[XB_TMO])) break; if (_sp > XB_SPIN_CAP) { atomicAdd(&(bar)[XB_TMO], 1u); break; } } } } while (0)

struct XcdBarrier {
    unsigned* bar; unsigned x;
    volatile LAS unsigned* st;
};

__device__ __forceinline__ XcdBarrier xcd_barrier_post(unsigned* bar, volatile LAS unsigned* st) {
    XcdBarrier b; b.bar = bar; b.x = xb_xcc_id(); b.st = st;
    if (threadIdx.x == 0) (void)xb_add(&bar[XB_XCNT(b.x)], 1u);
    return b;
}
__device__ __forceinline__ void xcd_barrier_complete(unsigned* bar, unsigned x, unsigned& nloc, unsigned& nx) {
    const unsigned G = gridDim.x * gridDim.y * gridDim.z;
    unsigned sum, cnt, mine, sp = 0u;
    for (;;) {
        sum = 0u; cnt = 0u; mine = 0u;
#pragma unroll
        for (unsigned j = 0; j < 16; ++j) { const unsigned c = xb_ld(&bar[XB_XCNT(j)]); sum += c; cnt += (c > 0u) ? 1u : 0u; mine = (j == x) ? c : mine; }
        if (sum == G) break;
        __builtin_amdgcn_s_sleep(1);
        if ((++sp & 255u) == 0u) { if (xb_ld(&bar[XB_TMO])) break; if (sp > XB_SPIN_CAP) { atomicAdd(&bar[XB_TMO], 1u); break; } }
    }
    nloc = mine > 0u ? mine : 1u; nx = cnt > 0u ? cnt : 1u;
}

__device__ __forceinline__ void xcd_barrier(const XcdBarrier& b) {
    asm volatile("s_waitcnt vmcnt(0)" ::: "memory");
    __syncthreads();
    if (threadIdx.x == 0) {
        unsigned* bar = b.bar;
        __builtin_amdgcn_s_waitcnt(0);
        unsigned nloc = b.st[0], nx = b.st[1];
        if (nloc == 0u) { xcd_barrier_complete(bar, b.x, nloc, nx); b.st[0] = nloc; b.st[1] = nx; }
        const unsigned old = xb_add(&bar[XB_XSUB(b.x)], 1u);
        const unsigned gen = old / nloc;
        if (old + 1u == (gen + 1u) * nloc) {
            __builtin_amdgcn_fence(__ATOMIC_RELEASE, "agent");
            asm volatile("s_waitcnt vmcnt(0)" ::: "memory");
            const unsigned og = xb_add(&bar[XB_TOP], 1u);
            const unsigned tg = og / nx;
            if (og + 1u == (tg + 1u) * nx) xb_add(&bar[XB_TOPGEN], 1u);
            else XB_SPIN(xb_ld(&bar[XB_TOPGEN]) == tg, bar);
            __builtin_amdgcn_fence(__ATOMIC_ACQUIRE, "agent");
            xb_add(&bar[XB_XGEN(b.x)], 1u);
            asm volatile("s_waitcnt vmcnt(0)" ::: "memory");
        } else {
            XB_SPIN(xb_ld(&bar[XB_XGEN(b.x)]) == gen, bar);
            __builtin_amdgcn_fence(__ATOMIC_ACQUIRE, "agent");
            asm volatile("s_waitcnt vmcnt(0)" ::: "memory");
        }
    }
    __syncthreads();
}

struct Args {
    const float *x, *p, *mix_norm_pre, *w_in, *lam_re, *lam_im, *log_dt, *b_re, *b_im, *c_re, *c_im, *ssm_d, *w_glu, *b_glu, *attn_norm, *ssm_norm,
                *w_out, *mix_norm_post, *mlp_norm_pre, *w_up, *w_down, *mlp_norm_post, *ple_norm_pre, *w_g, *w_p, *ple_norm_post;
    float* out; unsigned char* ws; int ph_lo, ph_hi;
};
constexpr int N_PHASES = 13;
#ifndef REP_MASK
#define REP_MASK 0
#endif

__global__ void __launch_bounds__(NTHREADS, 2) fwd_megakernel(Args a) {
    extern __shared__ __attribute__((aligned(16))) unsigned char lds_raw[];
    LAS unsigned char* lds = (LAS unsigned char*)lds_raw;
    const int tid = threadIdx.x, lane = tid & 63, wave = __builtin_amdgcn_readfirstlane(tid >> 6);
    const int G = gridDim.x, bx = blockIdx.x;
    const int vcu = (G % 8 == 0) ? (bx % 8) * (G / 8) + bx / 8 : bx;
    const int gw = vcu * NWAVES + wave, NGW = G * NWAVES;
    const int gt = vcu * NTHREADS + tid, NGT = G * NTHREADS;
    unsigned char* ws = a.ws;
    bf16* XN = (bf16*)(ws + WS_XN);
    const int lo = a.ph_lo, hi = a.ph_hi;
#define IN(k) (lo <= (k) && (k) < hi)
    volatile LAS unsigned* MISC = (volatile LAS unsigned*)(lds + LDS_BYTES - 256);
    if (tid < 32) MISC[tid] = 0u;
    __syncthreads();
    if (lo < 0) cg::this_grid().sync();
    XcdBarrier bar = xcd_barrier_post((unsigned*)ws, MISC + 8);
#define GSYNC() xcd_barrier(bar)
#define SEAM(k) do { if (IN(k) && IN((k) + 1)) GSYNC(); } while (0)
#define PH_BEGIN(k) for (int rep_ = 0; rep_ < (IN(k) ? 1 + ((REP_MASK >> (k)) & 1) : 0); ++rep_) { if (rep_) GSYNC();
    LAS float* scr = (LAS float*)(lds + wave * 16384);

    PH_BEGIN(0)
        constexpr int I_IN = (DM / 64) * (NPROJ / 32), I_GLU = (AW / 64) * (AW / 32), I_OUT = (DM / 64) * (DM / 32);
        for (int it = gw; it < I_IN + I_GLU + I_OUT; it += NGW) {
            int r = it;
            if (r < I_IN) { transpose_item(a.w_in, DM, NPROJ, (bf16*)(ws + WS_WIN), scr, r, lane); continue; } r -= I_IN;
            if (r < I_GLU) { transpose_item(a.w_glu, AW, AW, (bf16*)(ws + WS_WGLU), scr, r, lane); continue; } r -= I_GLU;
            transpose_item(a.w_out, DM, DM, (bf16*)(ws + WS_WOUT), scr, r, lane);
        }
        for (int m = gw; m < M_TOK; m += NGW) rms_row_to_bf16(a.x + (size_t)m * DM, a.mix_norm_pre, XN + (size_t)m * DM, lane);
        for (int id = gt; id < SG * SP; id += NGT) {
            const int g = id >> 6;
            const double lr = (double)a.lam_re[id], li = (double)a.lam_im[id], dt = exp_f64((double)a.log_dt[g]);
            double ar, ai; cexp_lam(lr, li, dt, ar, ai);
            f32x2* pw = (f32x2*)(ws + WS_PW) + (size_t)id * 33;
            double pr = 1.0, pi = 0.0;
            for (int t = 0; t <= 32; ++t) { pw[t] = (f32x2){(float)pr, (float)pi}; const double nr = pr * ar - pi * ai, ni = pr * ai + pi * ar; pr = nr; pi = ni; }
            const double nr = ar - 1.0, ni = ai, den = lr * lr + li * li;
            const double cr = (nr * lr + ni * li) / den, ci = (ni * lr - nr * li) / den;
            f32x2* bb = (f32x2*)(ws + WS_BBAR) + (size_t)id * 16;
            for (int c = 0; c < SC; ++c) { const double br_ = (double)a.b_re[(size_t)id * 16 + c], bi_ = (double)a.b_im[(size_t)id * 16 + c];
                bb[c] = (f32x2){(float)(cr * br_ - ci * bi_), (float)(cr * bi_ + ci * br_)}; }
        }
    }
    SEAM(0);
    PH_BEGIN(1)
        { pg8::Gemm g{XN, (const bf16*)(ws + WS_WIN), M_TOK, NPROJ, DM, DM, DM}; pg8::StaticOrder S; S.init(M_TOK, NPROJ, G, bx);
          pg8::EpiProj E{(bf16*)(ws + WS_Q), (size_t)(WS_K - WS_Q) / 2, (bf16*)(ws + WS_UG), QSCALE};
          static_assert(WS_V - WS_K == WS_K - WS_Q, "q, k, v equally spaced");
          pg8::gemm_phase<pg8::EpiProj, pg8::StaticOrder, true, true>(lds, g, S, E); }
        const f32x2* PW = (const f32x2*)(ws + WS_PW); const f32x2* BB = (const f32x2*)(ws + WS_BBAR);
        for (int id = gt; id < SG * 256 * CHL; id += NGT) {
            const int tp = id & 31, q = (id >> 5) & 255, g = id >> 13;
            bf16* dst = (bf16*)(ws + WS_HST) + ((size_t)(g * 256 + q)) * 512 + tp * 16;
            v4u w0 = (v4u){0u, 0u, 0u, 0u}, w1 = w0;
            if (q < 128) { const int p = q & 63, part = q >> 6; const f32x2 pw = PW[(size_t)(g * 64 + p) * 33 + (31 - tp)]; const f32x2* bb = BB + (size_t)(g * 64 + p) * 16;
                float v[16];
#pragma unroll
                for (int c = 0; c < 16; ++c) { const f32x2 b_ = bb[c]; v[c] = part == 0 ? (b_.x * pw.x - b_.y * pw.y) : (b_.x * pw.y + b_.y * pw.x); }
                w0 = (v4u){pk2(v[0], v[1]), pk2(v[2], v[3]), pk2(v[4], v[5]), pk2(v[6], v[7])}; w1 = (v4u){pk2(v[8], v[9]), pk2(v[10], v[11]), pk2(v[12], v[13]), pk2(v[14], v[15])}; }
            *(v4u*)dst = w0; *(v4u*)(dst + 8) = w1;
        }
    }
    SEAM(1);
    PH_BEGIN(2)
        const int att0 = (G >= 128) ? SG : 0;
        if (bx < SG) {
            { pg8::Gemm g{(const bf16*)(ws + WS_UG), (const bf16*)(ws + WS_HST), SG * 256, SG * 256, 512, UGK, 512}; pg8::StateOrder S{SG, G, bx};
              pg8::EpiE E{(float*)(ws + WS_E)};
              pg8::gemm_phase<pg8::EpiE, pg8::StateOrder, true, true>(lds, g, S, E); }
            asm volatile("s_waitcnt vmcnt(0)" ::: "memory"); __syncthreads(); __builtin_amdgcn_fence(__ATOMIC_ACQUIRE, "agent");
            for (int g = bx; g < SG; g += G) {
                if (wave < 2) {
                    const int b = wave, p = lane;
                    const f32x2 a32 = ((const f32x2*)(ws + WS_PW))[(size_t)(g * 64 + p) * 33 + 32];
                    const float* E = (const float*)(ws + WS_E) + ((size_t)(g * 256 + b * 128)) * 128; bf16* ug = (bf16*)(ws + WS_UG) + ((size_t)(g * 256 + b * 128)) * UGK + 512;
                    float sr = 0.f, si = 0.f;
                    for (int c0 = 0; c0 < 128; c0 += 32) {
                        float er[32], ei[32];
#pragma unroll
                        for (int k = 0; k < 32; ++k) { er[k] = E[(size_t)(c0 + k) * 128 + p]; ei[k] = E[(size_t)(c0 + k) * 128 + 64 + p]; }
#pragma unroll
                        for (int k = 0; k < 32; ++k) {
                            ug[(size_t)(c0 + k) * UGK + p] = (bf16)f2bf(sr); ug[(size_t)(c0 + k) * UGK + 64 + p] = (bf16)f2bf(si);
                            const float nr = a32.x * sr - a32.y * si + er[k], ni = a32.x * si + a32.y * sr + ei[k]; sr = nr; si = ni; }
                    }
                }
            }
        }
        if (bx >= att0) {
            for (int wu = (bx - att0) * NWAVES + wave; wu < 3 * 2 * NH * 32 * 4; wu += (G - att0) * NWAVES)
                attn_wave_unit(wu, (const bf16*)(ws + WS_Q), (const bf16*)(ws + WS_K), (const bf16*)(ws + WS_V), (bf16*)(ws + WS_OB), (float*)(ws + WS_LSE), lds + wave * 17408, lane);
        }
        {
            const f32x2* PW = (const f32x2*)(ws + WS_PW); const f32x2* BB = (const f32x2*)(ws + WS_BBAR);
            for (int w = bx; w < SG * 4; w += G) {
                const int g = w >> 2, q = w & 3;
                LAS f32x2* Cs = (LAS f32x2*)lds; LAS f32x2* Bs = (LAS f32x2*)(lds + 8192); LAS f32x2* Ps = (LAS f32x2*)(lds + 16384); LAS float* KTs = (LAS float*)(lds + 20480);
                __syncthreads();
#pragma unroll
                for (int e = 0; e < 2; ++e) { const int i = tid + e * NTHREADS; Cs[i] = (f32x2){a.c_re[(size_t)g * 1024 + i], a.c_im[(size_t)g * 1024 + i]}; Bs[i] = BB[(size_t)g * 1024 + i]; }
                Ps[tid] = PW[(size_t)(g * 64 + (tid >> 3)) * 33 + 8 * q + (tid & 7)];
                __syncthreads();
                { const int cc = tid & 255, c = cc >> 4, cp = cc & 15, th = tid >> 8;
                  float acc[4] = {0.f, 0.f, 0.f, 0.f};
#pragma unroll 4
                  for (int p = 0; p < SP; ++p) { const f32x2 cv = Cs[c * 64 + p], bv = Bs[p * 16 + cp];
#pragma unroll
                      for (int k = 0; k < 4; ++k) { const f32x2 pw = Ps[p * 8 + 4 * th + k]; const float wr = cv.x * pw.x - cv.y * pw.y, wi = cv.x * pw.y + cv.y * pw.x; acc[k] += wr * bv.x - wi * bv.y; } }
#pragma unroll
                  for (int k = 0; k < 4; ++k) KTs[(4 * th + k) * 256 + cc] = acc[k]; }
                __syncthreads();
                {
#pragma unroll 4
                  for (int it = 0; it < 16; ++it) {
                      const int id = it * NTHREADS + tid, row = id >> 4, pi = id & 15, kb = pi >> 1, half = pi & 1, t = row >> 4, c = row & 15;
                      bf16* rowp = (bf16*)(ws + WS_BSB) + ((size_t)(g * 512 + row)) * UGK + half * 8;
                      const int k = 7 - kb, tp = t - (8 * q + k);
                      if (tp >= 0) { const LAS f32x4* kt = (const LAS f32x4*)(KTs + k * 256 + c * 16 + half * 8); const f32x4 k0 = kt[0], k1 = kt[1];
                          *(v4u*)(rowp + tp * 16) = (v4u){pk2(k0.x, k0.y), pk2(k0.z, k0.w), pk2(k1.x, k1.y), pk2(k1.z, k1.w)}; }
                      const int tz = t + 1 + 8 * q + kb;
                      if (tz < CHL) *(v4u*)(rowp + tz * 16) = (v4u){0u, 0u, 0u, 0u};
                  } }
            }
            for (int id = gt; id < SG * 512 * 8; id += NGT) {
                const int qb = id & 7, rest = id >> 3, c = rest & 15, t = (rest >> 4) & 31, g = rest >> 9;
                bf16* dst = (bf16*)(ws + WS_BSB) + ((size_t)(g * 512 + t * 16 + c)) * UGK + 512 + qb * 16;
                float v[16];
#pragma unroll
                for (int i = 0; i < 16; ++i) { const int comp = qb * 16 + i, part = comp >> 6, p = comp & 63; const f32x2 pw = PW[(size_t)(g * 64 + p) * 33 + t + 1];
                    const float cr = a.c_re[(size_t)(g * 16 + c) * 64 + p], ci = a.c_im[(size_t)(g * 16 + c) * 64 + p];
                    v[i] = part == 0 ? (cr * pw.x - ci * pw.y) : -(cr * pw.y + ci * pw.x); }
                *(v4u*)dst = (v4u){pk2(v[0], v[1]), pk2(v[2], v[3]), pk2(v[4], v[5]), pk2(v[6], v[7])};
                *(v4u*)(dst + 8) = (v4u){pk2(v[8], v[9]), pk2(v[10], v[11]), pk2(v[12], v[13]), pk2(v[14], v[15])};
            }
        }
    }
    SEAM(2);
    PH_BEGIN(3)
        { pg8::Gemm g{(const bf16*)(ws + WS_UG), (const bf16*)(ws + WS_BSB), SG * 256, SG * 512, UGK, UGK, UGK}; pg8::OutOrder S{SG, G, bx};
          pg8::EpiY E{(const bf16*)(ws + WS_UG), a.ssm_d, (bf16*)(ws + WS_YB)};
          pg8::gemm_phase<pg8::EpiY, pg8::OutOrder, true, true>(lds, g, S, E); }
        const int nglu = (M_TOK / 256) * (AW / 256);
        const int r0 = (G > nglu) ? nglu : 0;
        if (bx >= r0) {
            const bf16* OB = (const bf16*)(ws + WS_OB); const float* LSE = (const float*)(ws + WS_LSE);
            for (int m = (bx - r0) * NWAVES + wave; m < M_TOK; m += (G - r0) * NWAVES) {
                const int h = lane >> 3;
                const float l0 = LSE[((size_t)0 * M_TOK + m) * NH + h], l1 = LSE[((size_t)1 * M_TOK + m) * NH + h], l2 = LSE[((size_t)2 * M_TOK + m) * NH + h];
                const float mx = fmaxf(l0, fmaxf(l1, l2));
                float w0 = __builtin_amdgcn_exp2f(l0 - mx), w1 = __builtin_amdgcn_exp2f(l1 - mx), w2 = __builtin_amdgcn_exp2f(l2 - mx);
                const float wi = 1.0f / (w0 + w1 + w2); w0 *= wi; w1 *= wi; w2 *= wi;
                float v[16]; float s = 0.f;
#pragma unroll
                for (int hf = 0; hf < 2; ++hf) {
                    const size_t off = (size_t)m * AW + lane * 16 + hf * 8;
                    const v4u x0 = *(const v4u*)(OB + off), x1 = *(const v4u*)(OB + OB_STRIDE + off), x2 = *(const v4u*)(OB + 2 * OB_STRIDE + off);
                    v[hf * 8 + 0] = w0 * bflo(x0.x) + w1 * bflo(x1.x) + w2 * bflo(x2.x); v[hf * 8 + 1] = w0 * bfhi(x0.x) + w1 * bfhi(x1.x) + w2 * bfhi(x2.x);
                    v[hf * 8 + 2] = w0 * bflo(x0.y) + w1 * bflo(x1.y) + w2 * bflo(x2.y); v[hf * 8 + 3] = w0 * bfhi(x0.y) + w1 * bfhi(x1.y) + w2 * bfhi(x2.y);
                    v[hf * 8 + 4] = w0 * bflo(x0.z) + w1 * bflo(x1.z) + w2 * bflo(x2.z); v[hf * 8 + 5] = w0 * bfhi(x0.z) + w1 * bfhi(x1.z) + w2 * bfhi(x2.z);
                    v[hf * 8 + 6] = w0 * bflo(x0.w) + w1 * bflo(x1.w) + w2 * bflo(x2.w); v[hf * 8 + 7] = w0 * bfhi(x0.w) + w1 * bfhi(x1.w) + w2 * bfhi(x2.w);
                }
#pragma unroll
                for (int i = 0; i < 16; ++i) s += v[i] * v[i];
                const float rs = 1.0f / sqrtf(wave_sum(s) * (1.0f / AW) + RMS_EPS);
                bf16* xo = XN + (size_t)m * DM + lane * 16;
#pragma unroll
                for (int hf = 0; hf < 2; ++hf) { const f32x4 g0 = *(const f32x4*)(a.attn_norm + lane * 16 + hf * 8), g1 = *(const f32x4*)(a.attn_norm + lane * 16 + hf * 8 + 4);
                    *(v4u*)(xo + hf * 8) = (v4u){pk2(v[hf * 8] * rs * g0.x, v[hf * 8 + 1] * rs * g0.y), pk2(v[hf * 8 + 2] * rs * g0.z, v[hf * 8 + 3] * rs * g0.w),
                                                 pk2(v[hf * 8 + 4] * rs * g1.x, v[hf * 8 + 5] * rs * g1.y), pk2(v[hf * 8 + 6] * rs * g1.z, v[hf * 8 + 7] * rs * g1.w)}; }
            }
        }
    }
    SEAM(3);
    PH_BEGIN(4)
        { pg8::Gemm g{(const bf16*)(ws + WS_YB), (const bf16*)(ws + WS_WGLU), M_TOK, AW, AW, AW, AW}; pg8::StaticOrder S; S.init(M_TOK, AW, G, bx);
          pg8::EpiGLU E{(const bf16*)(ws + WS_YB), a.b_glu, (bf16*)(ws + WS_SSMO)};
          pg8::gemm_phase<pg8::EpiGLU, pg8::StaticOrder, true, true>(lds, g, S, E); }
    }
    SEAM(4);
    PH_BEGIN(5)
        const bf16* SO = (const bf16*)(ws + WS_SSMO);
        for (int m = gw; m < M_TOK; m += NGW) {
            float v[16]; float s = 0.f;
#pragma unroll
            for (int hf = 0; hf < 2; ++hf) { const v4u x0 = *(const v4u*)(SO + (size_t)m * AW + lane * 16 + hf * 8);
                v[hf * 8 + 0] = bflo(x0.x); v[hf * 8 + 1] = bfhi(x0.x); v[hf * 8 + 2] = bflo(x0.y); v[hf * 8 + 3] = bfhi(x0.y);
                v[hf * 8 + 4] = bflo(x0.z); v[hf * 8 + 5] = bfhi(x0.z); v[hf * 8 + 6] = bflo(x0.w); v[hf * 8 + 7] = bfhi(x0.w); }
#pragma unroll
            for (int i = 0; i < 16; ++i) s += v[i] * v[i];
            const float rs = 1.0f / sqrtf(wave_sum(s) * (1.0f / AW) + RMS_EPS);
            bf16* xo = XN + (size_t)m * DM + AW + lane * 16;
#pragma unroll
            for (int hf = 0; hf < 2; ++hf) { const f32x4 g0 = *(const f32x4*)(a.ssm_norm + lane * 16 + hf * 8), g1 = *(const f32x4*)(a.ssm_norm + lane * 16 + hf * 8 + 4);
                *(v4u*)(xo + hf * 8) = (v4u){pk2(v[hf * 8] * rs * g0.x, v[hf * 8 + 1] * rs * g0.y), pk2(v[hf * 8 + 2] * rs * g0.z, v[hf * 8 + 3] * rs * g0.w),
                                             pk2(v[hf * 8 + 4] * rs * g1.x, v[hf * 8 + 5] * rs * g1.y), pk2(v[hf * 8 + 6] * rs * g1.z, v[hf * 8 + 7] * rs * g1.w)}; }
        }
    }
    SEAM(5);
    PH_BEGIN(6)
        pg8::Gemm g{XN, (const bf16*)(ws + WS_WOUT), M_TOK, DM, DM, DM, DM}; pg8::StaticOrder S; S.init(M_TOK, DM, G, bx);
        pg8::EpiBf16Plain E{(bf16*)(ws + WS_MIX), DM};
        pg8::gemm_phase<pg8::EpiBf16Plain, pg8::StaticOrder, true, true>(lds, g, S, E);
    }
    SEAM(6);
    PH_BEGIN(7)
        for (int m = gw; m < M_TOK; m += NGW)
            residual_row<true>((const bf16*)(ws + WS_MIX) + (size_t)m * DM, a.mix_norm_post, a.x + (size_t)m * DM, a.out + (size_t)m * DM, a.mlp_norm_pre, XN + (size_t)m * DM, lane);
        constexpr int I_UP = (DM / 64) * (DFF / 32), I_DOWN = (DFF / 64) * (DM / 32), I_G = (DM / 64) * (DM / 32), I_P = (PLE / 64) * (DM / 32);
        for (int it = gw; it < I_UP + I_DOWN + I_G + I_P; it += NGW) {
            int r = it;
            if (r < I_UP) { transpose_item(a.w_up, DM, DFF, (bf16*)(ws + WS_WUP), scr, r, lane); continue; } r -= I_UP;
            if (r < I_DOWN) { transpose_item(a.w_down, DFF, DM, (bf16*)(ws + WS_WDOWN), scr, r, lane); continue; } r -= I_DOWN;
            if (r < I_G) { transpose_item(a.w_g, DM, DM, (bf16*)(ws + WS_WG), scr, r, lane); continue; } r -= I_G;
            transpose_item(a.w_p, PLE, DM, (bf16*)(ws + WS_WP), scr, r, lane);
        }
        for (int id = gt; id < M_TOK * PLE / 4; id += NGT) { const f32x4 v = ((const f32x4*)a.p)[id]; ((v2u*)(ws + WS_PB))[id] = (v2u){pk2(v.x, v.y), pk2(v.z, v.w)}; }
    }
    SEAM(7);
    PH_BEGIN(8)
        pg8::Gemm g{XN, (const bf16*)(ws + WS_WUP), M_TOK, DFF, DM, DM, DM}; pg8::StaticOrder S; S.init(M_TOK, DFF, G, bx);
        pg8::EpiRelu2 E{(bf16*)(ws + WS_HID), DFF};
        pg8::gemm_phase<pg8::EpiRelu2, pg8::StaticOrder, true, true>(lds, g, S, E);
    }
    SEAM(8);
    PH_BEGIN(9)
        pg8::Gemm g{(const bf16*)(ws + WS_HID), (const bf16*)(ws + WS_WDOWN), M_TOK, DM, DFF, DFF, DFF}; pg8::StaticOrder S; S.init(M_TOK, DM, G, bx);
        pg8::EpiBf16Plain E{(bf16*)(ws + WS_FF), DM};
        pg8::gemm_phase<pg8::EpiBf16Plain, pg8::StaticOrder, true, true>(lds, g, S, E);
    }
    SEAM(9);
    PH_BEGIN(10)
        { pg8::Gemm g{(const bf16*)(ws + WS_PB), (const bf16*)(ws + WS_WP), M_TOK, DM, PLE, PLE, PLE}; pg8::StaticOrder S; S.init(M_TOK, DM, G, bx);
          pg8::EpiBf16Plain E{(bf16*)(ws + WS_GE), DM};
          pg8::gemm_phase<pg8::EpiBf16Plain, pg8::StaticOrder, true, true>(lds, g, S, E); }
        for (int m = gw; m < M_TOK; m += NGW)
            residual_row<true>((const bf16*)(ws + WS_FF) + (size_t)m * DM, a.mlp_norm_post, a.out + (size_t)m * DM, a.out + (size_t)m * DM, a.ple_norm_pre, (bf16*)(ws + WS_XN3) + (size_t)m * DM, lane);
    }
    SEAM(10);
    PH_BEGIN(11)
        pg8::Gemm g{(const bf16*)(ws + WS_XN3), (const bf16*)(ws + WS_WG), M_TOK, DM, DM, DM, DM}; pg8::StaticOrder S; S.init(M_TOK, DM, G, bx);
        pg8::EpiGateBf E{(bf16*)(ws + WS_GE), DM};
        pg8::gemm_phase<pg8::EpiGateBf, pg8::StaticOrder, true, true>(lds, g, S, E);
    }
    SEAM(11);
    PH_BEGIN(12)
        for (int m = gw; m < M_TOK; m += NGW)
            residual_row<false>((const bf16*)(ws + WS_GE) + (size_t)m * DM, a.ple_norm_post, a.out + (size_t)m * DM, a.out + (size_t)m * DM, nullptr, nullptr, lane);
    }
#undef IN
#undef SEAM
}

#ifndef MK_PER_PHASE
#define MK_PER_PHASE 0
#endif
extern "C" void kernel_launch(void* const* d_in, const int* in_sizes, int n_in, void* d_out, int out_size, void* d_ws, size_t ws_size, hipStream_t stream) {
    static int grid = 0;
    if (grid == 0) {
        if (n_in != 26 || in_sizes[0] != M_TOK * DM || out_size != M_TOK * DM || ws_size < WS_END) { fprintf(stderr, "kernel_launch: unexpected shapes / workspace (n_in %d, ws %zu)\n", n_in, ws_size); grid = -1; return; }
        int dev = 0, cus = 0, per_cu = 0;
        if (hipGetDevice(&dev) != hipSuccess || hipDeviceGetAttribute(&cus, hipDeviceAttributeMultiprocessorCount, dev) != hipSuccess) { grid = -1; return; }
        if (hipFuncSetAttribute((const void*)fwd_megakernel, hipFuncAttributeMaxDynamicSharedMemorySize, LDS_BYTES) != hipSuccess) { fprintf(stderr, "kernel_launch: hipFuncSetAttribute failed\n"); grid = -1; return; }
        if (hipOccupancyMaxActiveBlocksPerMultiprocessor(&per_cu, (const void*)fwd_megakernel, NTHREADS, LDS_BYTES) != hipSuccess || per_cu < 1) { fprintf(stderr, "kernel_launch: occupancy query says %d blocks per CU\n", per_cu); (void)hipGetLastError(); grid = -1; return; }
        grid = cus;
    }
    if (grid < 0) return;
    Args a{};
    const float** ap = (const float**)&a;
    for (int i = 0; i < 26; ++i) ap[i] = (const float*)d_in[i];
    a.out = (float*)d_out; a.ws = (unsigned char*)d_ws;
#if MK_PER_PHASE
    for (int ph = 0; ph < N_PHASES; ++ph) { a.ph_lo = ph; a.ph_hi = ph + 1; hipLaunchKernelGGL(fwd_megakernel, dim3(grid), dim3(NTHREADS), LDS_BYTES, stream, a); }
#else
    if (hipMemsetAsync(d_ws, 0, 65536, stream) != hipSuccess) { fprintf(stderr, "kernel_launch: memset failed\n"); return; }
    a.ph_lo = 0; a.ph_hi = N_PHASES;
    void* kargs[] = {&a};
    hipError_t e = hipLaunchCooperativeKernel((const void*)fwd_megakernel, dim3(grid), dim3(NTHREADS), kargs, LDS_BYTES, stream);
    if (e != hipSuccess) fprintf(stderr, "kernel_launch: cooperative launch failed: %s (grid %d)\n", hipGetErrorString(e), grid);
#endif
}
```

```cpp
#include <hip/hip_runtime.h>
#include <hip/hip_cooperative_groups.h>
#include <cstdio>
#include <cstdint>
namespace cg = cooperative_groups;
namespace pg8 {
#define PG8_LAS __attribute__((address_space(3)))
typedef unsigned short bf16_t;
typedef short bf16x8 __attribute__((ext_vector_type(8)));
typedef float f32x4 __attribute__((ext_vector_type(4)));
typedef unsigned u32x4 __attribute__((ext_vector_type(4)));
constexpr int BM = 256, BK = 64, HALF = 128, HTB = HALF * BK * 2  , STAGE_BYTES = 8 * HTB, NXCD = 8, WGM = 8;

__host__ __device__ __forceinline__ int lds_byte(int r, int c) { const int st = (r >> 4) * 2 + (c >> 5), rr = r & 15, cc = c & 31, ob = rr * 64 + cc * 2; return st * 1024 + (ob ^ (((ob >> 9) & 1) << 5)); }
__host__ __device__ __forceinline__ void stage_rc(int b, int& R, int& C) { const int st = b / 1024, sb = b % 1024, swz = sb ^ (((sb >> 9) & 1) << 5); R = (st >> 1) * 16 + swz / 64; C = (st & 1) * 32 + (swz % 64) / 2; }
__host__ __device__ __forceinline__ int perm32(int rho) { const int n = rho >> 4, i = rho & 15; return 8 * (i >> 2) + 4 * n + (i & 3); }

struct Unit { int pm, pn; };
struct Gemm { const bf16_t* A; const bf16_t* Bt; int M, N, K, lda, ldb; };

struct StaticOrder {
    int nM, nN, nwg, G, c;
    __host__ __device__ void init(int M, int N, int G_, int c_) { nM = M / BM; nN = N / BM; nwg = nM * nN; G = G_; c = c_; }
    __host__ __device__ bool next(int i, Unit& u) const {
        const long L = (long)i * G + c; if (L >= nwg) return false;
        int wgid = (int)L; { const int q = nwg / NXCD, r = nwg % NXCD, xcd = wgid % NXCD, off = wgid / NXCD; wgid = (xcd < r ? xcd * (q + 1) : r * (q + 1) + (xcd - r) * q) + off; }
        const int nig = WGM * nN, gid = wgid / nig, fm = gid * WGM, gsz = (nM - fm) < WGM ? (nM - fm) : WGM;
        u.pm = fm + ((wgid % nig) % gsz); u.pn = (wgid % nig) / gsz; return true;
    }
    __device__ __forceinline__ void a_ready(const Unit&) const {}
    __device__ __forceinline__ void done(const Unit&) const {}
};

struct GroupOrder {
    int nj, total, G, c;
    __device__ __forceinline__ bool next(int i, Unit& u) const { const int id = i * G + c; if (id >= total) return false; const int g = id / nj; u.pm = g; u.pn = g * nj + (id - g * nj); return true; }
    __device__ __forceinline__ void a_ready(const Unit&) const {}
    __device__ __forceinline__ void done(const Unit&) const {}
};

struct StateOrder { int ng, G, c;
    __device__ __forceinline__ bool next(int i, Unit& u) const { const int g = c + i * G; if (g >= ng) return false; u.pm = g; u.pn = g; return true; }
    __device__ __forceinline__ void a_ready(const Unit&) const {}
    __device__ __forceinline__ void done(const Unit&) const {} };
struct OutOrder { int ng, G, c;
    __device__ __forceinline__ bool next(int i, Unit& u) const { const int id = c + i * G; if (id >= 2 * ng) return false; u.pm = id >> 1; u.pn = id; return true; }
    __device__ __forceinline__ void a_ready(const Unit&) const {}
    __device__ __forceinline__ void done(const Unit&) const {} };
__device__ __forceinline__ unsigned f2bf(float f) { unsigned u = __builtin_bit_cast(unsigned, f); return (u + 0x7fffu + ((u >> 16) & 1u)) >> 16; }
__device__ __forceinline__ unsigned pk2(float lo, float hi) { return f2bf(lo) | (f2bf(hi) << 16); }
__device__ __forceinline__ float bflo(unsigned w) { return __builtin_bit_cast(float, w << 16); }
__device__ __forceinline__ float bfhi(unsigned w) { return __builtin_bit_cast(float, w & 0xffff0000u); }
__device__ __forceinline__ u32x4 pack8(const f32x4& v0, const f32x4& v1) { u32x4 w; w.x = pk2(v0[0], v0[1]); w.y = pk2(v0[2], v0[3]); w.z = pk2(v1[0], v1[1]); w.w = pk2(v1[2], v1[3]); return w; }
__device__ __forceinline__ float sigmoidf_(float x) { return __builtin_amdgcn_rcpf(1.0f + __expf(-x)); }
__device__ __forceinline__ float gelu_tanh(float x) { const float z = 0.7978845608028654f * (x + 0.044715f * x * x * x); return x * __builtin_amdgcn_rcpf(1.0f + __expf(-2.0f * z)); }

struct EpiProj {
    static constexpr bool PERM = true, AFTER_DRAIN = false;
    bf16_t* Q; size_t split_stride; bf16_t* UG; float qscale;
    __device__ __forceinline__ void operator()(const f32x4 (&acc)[2][2][4][2], const Unit& u, int wr, int wc, int fr, int fq) const {
        const int row0 = u.pm * BM + wr * 64 + fr; const int t = u.pn >> 2; const int colt = (u.pn & 3) * BM + wc * 32 + 8 * fq;
        const float sc = 1.f + (t == 0 ? 1.f : 0.f) * (qscale - 1.f);
        bf16_t* base = Q + (size_t)(t < 3 ? t : 0) * split_stride;
#pragma unroll
        for (int ai = 0; ai < 2; ++ai)
#pragma unroll
            for (int m = 0; m < 4; ++m) { const int row = row0 + ai * HALF + m * 16;
#pragma unroll
                for (int bj = 0; bj < 2; ++bj) { const f32x4 v0 = acc[ai][bj][m][0] * sc, v1 = acc[ai][bj][m][1] * sc; const u32x4 w = pack8(v0, v1); const int col = colt + bj * HALF;
                    if (t < 3) *(u32x4*)(base + (size_t)row * 1024 + col) = w;
                    else { const int g = col >> 4, c = col & 15, cr = row >> 5, tt = row & 31; *(u32x4*)(UG + ((size_t)(g * 256 + cr)) * 640 + tt * 16 + c) = w; } } }
    }
};
struct EpiE {
    static constexpr bool PERM = false, AFTER_DRAIN = false;
    float* E;
    __device__ __forceinline__ void operator()(const f32x4 (&acc)[2][2][4][2], const Unit& u, int wr, int wc, int fr, int fq) const {
#pragma unroll
        for (int ai = 0; ai < 2; ++ai)
#pragma unroll
            for (int m = 0; m < 4; ++m) { const int r = ai * HALF + wr * 64 + m * 16 + fr;
#pragma unroll
                for (int n = 0; n < 2; ++n) *(f32x4*)(E + ((size_t)(u.pm * 256 + r)) * 128 + wc * 32 + 16 * n + 4 * fq) = acc[ai][0][m][n]; }
    }
};
struct EpiY {
    static constexpr bool PERM = true, AFTER_DRAIN = false;
    const bf16_t* UG; const float* Dskip; bf16_t* YB;
    __device__ __forceinline__ void operator()(const f32x4 (&acc)[2][2][4][2], const Unit& u, int wr, int wc, int fr, int fq) const {
        const int g = u.pm, j = u.pn - 2 * g;
#pragma unroll
        for (int bj = 0; bj < 2; ++bj) { const int cgc = j * 256 + bj * HALF + wc * 32 + 8 * fq; const int t = cgc >> 4, c = cgc & 15, ch = g * 16 + c;
            const f32x4 d0 = *(const f32x4*)(Dskip + ch), d1 = *(const f32x4*)(Dskip + ch + 4);
#pragma unroll
            for (int ai = 0; ai < 2; ++ai)
#pragma unroll
                for (int m = 0; m < 4; ++m) { const int r = ai * HALF + wr * 64 + m * 16 + fr;
                    const u32x4 uw = *(const u32x4*)(UG + ((size_t)(g * 256 + r)) * 640 + cgc);
                    f32x4 v0 = acc[ai][bj][m][0], v1 = acc[ai][bj][m][1];
                    v0[0] += d0[0] * bflo(uw.x); v0[1] += d0[1] * bfhi(uw.x); v0[2] += d0[2] * bflo(uw.y); v0[3] += d0[3] * bfhi(uw.y);
                    v1[0] += d1[0] * bflo(uw.z); v1[1] += d1[1] * bfhi(uw.z); v1[2] += d1[2] * bflo(uw.w); v1[3] += d1[3] * bfhi(uw.w);
#pragma unroll
                    for (int e = 0; e < 4; ++e) { v0[e] = gelu_tanh(v0[e]); v1[e] = gelu_tanh(v1[e]); }
                    *(u32x4*)(YB + ((size_t)(r * 32 + t)) * 1024 + ch) = pack8(v0, v1); } }
    }
};
struct EpiGLU {
    static constexpr bool PERM = true, AFTER_DRAIN = false;
    const bf16_t* YB; const float* bias; bf16_t* O;
    __device__ __forceinline__ void operator()(const f32x4 (&acc)[2][2][4][2], const Unit& u, int wr, int wc, int fr, int fq) const {
        const int row0 = u.pm * BM + wr * 64 + fr;
#pragma unroll
        for (int bj = 0; bj < 2; ++bj) { const int col = u.pn * BM + bj * HALF + wc * 32 + 8 * fq;
            const f32x4 b0 = *(const f32x4*)(bias + col), b1 = *(const f32x4*)(bias + col + 4);
#pragma unroll
            for (int ai = 0; ai < 2; ++ai)
#pragma unroll
                for (int m = 0; m < 4; ++m) { const size_t off = (size_t)(row0 + ai * HALF + m * 16) * 1024 + col;
                    const u32x4 yw = *(const u32x4*)(YB + off);
                    f32x4 v0 = acc[ai][bj][m][0] + b0, v1 = acc[ai][bj][m][1] + b1;
                    v0[0] = bflo(yw.x) * sigmoidf_(v0[0]); v0[1] = bfhi(yw.x) * sigmoidf_(v0[1]); v0[2] = bflo(yw.y) * sigmoidf_(v0[2]); v0[3] = bfhi(yw.y) * sigmoidf_(v0[3]);
                    v1[0] = bflo(yw.z) * sigmoidf_(v1[0]); v1[1] = bfhi(yw.z) * sigmoidf_(v1[1]); v1[2] = bflo(yw.w) * sigmoidf_(v1[2]); v1[3] = bfhi(yw.w) * sigmoidf_(v1[3]);
                    *(u32x4*)(O + off) = pack8(v0, v1); } }
    }
};
struct EpiF32 {
    static constexpr bool PERM = false, AFTER_DRAIN = false;
    float* O; int ldc;
    __device__ __forceinline__ void operator()(const f32x4 (&acc)[2][2][4][2], const Unit& u, int wr, int wc, int fr, int fq) const {
        const int row0 = u.pm * BM + wr * 64 + fr, col0 = u.pn * BM + wc * 32 + 4 * fq;
#pragma unroll
        for (int ai = 0; ai < 2; ++ai)
#pragma unroll
            for (int m = 0; m < 4; ++m) { float* rowp = O + (size_t)(row0 + ai * HALF + m * 16) * ldc + col0;
#pragma unroll
                for (int bj = 0; bj < 2; ++bj)
#pragma unroll
                    for (int n = 0; n < 2; ++n) *(f32x4*)(rowp + bj * HALF + n * 16) = acc[ai][bj][m][n]; }
    }
};
struct EpiBf16Plain {
    static constexpr bool PERM = true, AFTER_DRAIN = false;
    bf16_t* O; int ldc;
    __device__ __forceinline__ void operator()(const f32x4 (&acc)[2][2][4][2], const Unit& u, int wr, int wc, int fr, int fq) const {
        const int row0 = u.pm * BM + wr * 64 + fr, col0 = u.pn * BM + wc * 32 + 8 * fq;
#pragma unroll
        for (int ai = 0; ai < 2; ++ai)
#pragma unroll
            for (int m = 0; m < 4; ++m) { bf16_t* rowp = O + (size_t)(row0 + ai * HALF + m * 16) * ldc + col0;
#pragma unroll
                for (int bj = 0; bj < 2; ++bj) *(u32x4*)(rowp + bj * HALF) = pack8(acc[ai][bj][m][0], acc[ai][bj][m][1]); }
    }
};
struct EpiGateBf {
    static constexpr bool PERM = true, AFTER_DRAIN = false;
    bf16_t* GE; int ldc;
    __device__ __forceinline__ void operator()(const f32x4 (&acc)[2][2][4][2], const Unit& u, int wr, int wc, int fr, int fq) const {
        const int row0 = u.pm * BM + wr * 64 + fr, col0 = u.pn * BM + wc * 32 + 8 * fq;
#pragma unroll
        for (int ai = 0; ai < 2; ++ai)
#pragma unroll
            for (int m = 0; m < 4; ++m) { bf16_t* rowp = GE + (size_t)(row0 + ai * HALF + m * 16) * ldc + col0;
#pragma unroll
                for (int bj = 0; bj < 2; ++bj) { const u32x4 ew = *(const u32x4*)(rowp + bj * HALF); f32x4 v0 = acc[ai][bj][m][0], v1 = acc[ai][bj][m][1];
                    v0[0] = bflo(ew.x) * sigmoidf_(v0[0]); v0[1] = bfhi(ew.x) * sigmoidf_(v0[1]); v0[2] = bflo(ew.y) * sigmoidf_(v0[2]); v0[3] = bfhi(ew.y) * sigmoidf_(v0[3]);
                    v1[0] = bflo(ew.z) * sigmoidf_(v1[0]); v1[1] = bfhi(ew.z) * sigmoidf_(v1[1]); v1[2] = bflo(ew.w) * sigmoidf_(v1[2]); v1[3] = bfhi(ew.w) * sigmoidf_(v1[3]);
                    *(u32x4*)(rowp + bj * HALF) = pack8(v0, v1); } }
    }
};
struct EpiRelu2 {
    static constexpr bool PERM = true, AFTER_DRAIN = false;
    bf16_t* O; int ldc;
    __device__ __forceinline__ void operator()(const f32x4 (&acc)[2][2][4][2], const Unit& u, int wr, int wc, int fr, int fq) const {
        const int row0 = u.pm * BM + wr * 64 + fr, col0 = u.pn * BM + wc * 32 + 8 * fq;
#pragma unroll
        for (int ai = 0; ai < 2; ++ai)
#pragma unroll
            for (int m = 0; m < 4; ++m) { bf16_t* rowp = O + (size_t)(row0 + ai * HALF + m * 16) * ldc + col0;
#pragma unroll
                for (int bj = 0; bj < 2; ++bj) { f32x4 v0 = acc[ai][bj][m][0], v1 = acc[ai][bj][m][1];
#pragma unroll
                    for (int e = 0; e < 4; ++e) { const float a = fmaxf(v0[e], 0.f), b = fmaxf(v1[e], 0.f); v0[e] = a * a; v1[e] = b * b; }
                    *(u32x4*)(rowp + bj * HALF) = pack8(v0, v1); } }
    }
};
struct EpiGate {
    static constexpr bool PERM = false, AFTER_DRAIN = false;
    float* GE; int ldc;
    __device__ __forceinline__ void operator()(const f32x4 (&acc)[2][2][4][2], const Unit& u, int wr, int wc, int fr, int fq) const {
        const int row0 = u.pm * BM + wr * 64 + fr, col0 = u.pn * BM + wc * 32 + 4 * fq;
#pragma unroll
        for (int ai = 0; ai < 2; ++ai)
#pragma unroll
            for (int m = 0; m < 4; ++m) { float* rowp = GE + (size_t)(row0 + ai * HALF + m * 16) * ldc + col0;
#pragma unroll
                for (int bj = 0; bj < 2; ++bj)
#pragma unroll
                    for (int n = 0; n < 2; ++n) { const f32x4 e = *(const f32x4*)(rowp + bj * HALF + n * 16); const f32x4 a = acc[ai][bj][m][n]; f32x4 o;
#pragma unroll
                        for (int q = 0; q < 4; ++q) o[q] = e[q] * sigmoidf_(a[q]);
                        *(f32x4*)(rowp + bj * HALF + n * 16) = o; } }
    }
};

template <class Epi, class Sched, bool ALIGN_EPI = false, bool SP2 = false>
__device__ __forceinline__ void gemm_phase(PG8_LAS unsigned char* lds, const Gemm g, const Sched& S, const Epi& E) {
    const int tid = threadIdx.x, wid = __builtin_amdgcn_readfirstlane(tid >> 6), lane = tid & 63, wr = wid >> 2, wc = wid & 3, fr = lane & 15, fq = lane >> 4;
    const int K = g.K, nt = K / BK;
    unsigned voffA[2], voffB[2];
#pragma unroll
    for (int i = 0; i < 2; ++i) { int R, C; stage_rc(tid * 16 + i * 8192, R, C); const int Rb = Epi::PERM ? ((R & ~31) + perm32(R & 31)) : R;
        voffA[i] = (unsigned)(R * g.lda + C) * 2u; voffB[i] = (unsigned)(Rb * g.ldb + C) * 2u; }
    const size_t kstep = (size_t)(BK * 2);
    const size_t hstepA = (size_t)HALF * g.lda * 2, hstepB = (size_t)HALF * g.ldb * 2;
    const size_t tstepA = 2 * hstepA, tstepB = 2 * hstepB;
    const unsigned ldsw = (unsigned)wid * 1024u;
    const int aoff = lds_byte(wr * 64 + fr, fq * 8), boff = lds_byte(wc * 32 + fr, fq * 8);
#define PG8_SA(b, h) (((b) * 2 + (h)) * HTB)
#define PG8_SB(b, h) ((4 + (b) * 2 + (h)) * HTB)
#define PG8_STAGE(bufoff, gbase, voff) do { _Pragma("unroll") for (int _i = 0; _i < 2; ++_i) \
        __builtin_amdgcn_global_load_lds((const unsigned*)((const char*)(gbase) + (voff)[_i]), (PG8_LAS unsigned*)(lds + (bufoff) + ldsw + _i * 8192), 16, 0, 0); } while (0)
#define PG8_LDA(dst, b, h) do { _Pragma("unroll") for (int m = 0; m < 4; ++m) _Pragma("unroll") for (int k = 0; k < 2; ++k) dst[m][k] = *(const PG8_LAS bf16x8*)(lds + PG8_SA(b, h) + aoff + m * 2048 + k * 1024); } while (0)
#define PG8_LDB(dst, b, h) do { _Pragma("unroll") for (int n = 0; n < 2; ++n) _Pragma("unroll") for (int k = 0; k < 2; ++k) dst[n][k] = *(const PG8_LAS bf16x8*)(lds + PG8_SB(b, h) + boff + n * 2048 + k * 1024); } while (0)
#define PG8_MMA(ai, bj, At, Bt) do { __builtin_amdgcn_s_setprio(1); _Pragma("unroll") for (int m = 0; m < 4; ++m) _Pragma("unroll") for (int n = 0; n < 2; ++n) _Pragma("unroll") for (int k = 0; k < 2; ++k) \
        acc[ai][bj][m][n] = __builtin_amdgcn_mfma_f32_16x16x32_bf16(Bt[n][k], At[m][k], acc[ai][bj][m][n], 0, 0, 0); __builtin_amdgcn_s_setprio(0); } while (0)
#define PG8_WAIT_V(n) asm volatile("s_waitcnt vmcnt(" #n ")" ::: "memory")
#define PG8_WAIT_L(n) asm volatile("s_waitcnt lgkmcnt(" #n ")" ::: "memory")
#define PG8_BAR __builtin_amdgcn_s_barrier()
#define PG8_SCHED __builtin_amdgcn_sched_barrier(0)
    Unit cur, nxt; int ui = 0;
    if (!S.next(0, cur)) return;
    f32x4 acc[2][2][4][2];
#pragma unroll
    for (int a = 0; a < 2; ++a)
#pragma unroll
        for (int b = 0; b < 2; ++b)
#pragma unroll
            for (int m = 0; m < 4; ++m)
#pragma unroll
                for (int n = 0; n < 2; ++n) acc[a][b][m][n] = (f32x4){0.f, 0.f, 0.f, 0.f};
    bf16x8 At[4][2], B0[2][2], B1[2][2];
    const char* cA = (const char*)g.A + (size_t)cur.pm * tstepA; const char* cB = (const char*)g.Bt + (size_t)cur.pn * tstepB;
    S.a_ready(cur);
    if constexpr (SP2) {
        PG8_STAGE(PG8_SB(0, 0), cB, voffB); PG8_STAGE(PG8_SB(0, 1), cB + hstepB, voffB); PG8_STAGE(PG8_SA(0, 0), cA, voffA); PG8_STAGE(PG8_SA(0, 1), cA + hstepA, voffA);
        if (wr == 1) PG8_BAR;
        PG8_WAIT_V(2); PG8_BAR;
        PG8_STAGE(PG8_SB(1, 0), cB + kstep, voffB); PG8_STAGE(PG8_SA(1, 0), cA + kstep, voffA); PG8_STAGE(PG8_SB(1, 1), cB + hstepB + kstep, voffB);
        PG8_WAIT_V(6); PG8_BAR;
    } else {
        PG8_STAGE(PG8_SB(0, 0), cB, voffB); PG8_STAGE(PG8_SA(0, 0), cA, voffA); PG8_STAGE(PG8_SB(0, 1), cB + hstepB, voffB); PG8_STAGE(PG8_SA(0, 1), cA + hstepA, voffA);
        if (wr == 1) PG8_BAR;
        PG8_WAIT_V(4); PG8_BAR;
        PG8_STAGE(PG8_SB(1, 0), cB + kstep, voffB); PG8_STAGE(PG8_SA(1, 0), cA + kstep, voffA); PG8_STAGE(PG8_SB(1, 1), cB + hstepB + kstep, voffB);
        PG8_WAIT_V(6); PG8_BAR;
    }
    for (;;) {
        const bool has_next = S.next(ui + 1, nxt);
        const char* nA = has_next ? (const char*)g.A + (size_t)nxt.pm * tstepA : cA; const char* nB = has_next ? (const char*)g.Bt + (size_t)nxt.pn * tstepB : cB;
        for (int t = 0; t < nt; t += 2) {
            const bool last = (t == nt - 2);
            const char* a1 = cA + (size_t)(t + 1) * kstep;
            const char* a2 = last ? nA : cA + (size_t)(t + 2) * kstep; const char* b2 = last ? nB : cB + (size_t)(t + 2) * kstep;
            const char* a3 = a2 + kstep; const char* b3 = b2 + kstep;
            if (last && has_next) S.a_ready(nxt);
            if constexpr (SP2) {
            PG8_LDB(B0, 0, 0); PG8_LDB(B1, 0, 1); PG8_SCHED; PG8_LDA(At, 0, 0); PG8_STAGE(PG8_SA(1, 1), a1 + hstepA, voffA);
            PG8_WAIT_V(8); PG8_WAIT_L(0); PG8_BAR; PG8_MMA(0, 0, At, B0); PG8_MMA(0, 1, At, B1); PG8_BAR; PG8_SCHED;
            PG8_LDA(At, 0, 1); PG8_STAGE(PG8_SB(0, 0), b2, voffB); PG8_STAGE(PG8_SB(0, 1), b2 + hstepB, voffB); PG8_STAGE(PG8_SA(0, 0), a2, voffA);
            PG8_WAIT_V(8); PG8_WAIT_L(0); PG8_BAR; PG8_MMA(1, 0, At, B0); PG8_MMA(1, 1, At, B1); PG8_BAR; PG8_SCHED;
            PG8_LDB(B0, 1, 0); PG8_LDB(B1, 1, 1); PG8_SCHED; PG8_LDA(At, 1, 0); PG8_STAGE(PG8_SA(0, 1), a2 + hstepA, voffA);
            PG8_WAIT_V(8); PG8_WAIT_L(0); PG8_BAR; PG8_MMA(0, 0, At, B0); PG8_MMA(0, 1, At, B1); PG8_BAR; PG8_SCHED;
            PG8_LDA(At, 1, 1); PG8_STAGE(PG8_SB(1, 0), b3, voffB); PG8_STAGE(PG8_SB(1, 1), b3 + hstepB, voffB); PG8_STAGE(PG8_SA(1, 0), a3, voffA);
            PG8_WAIT_V(8); PG8_WAIT_L(0); PG8_BAR; PG8_MMA(1, 0, At, B0); PG8_MMA(1, 1, At, B1); PG8_BAR; PG8_SCHED;
            } else {
            PG8_LDB(B0, 0, 0); PG8_SCHED; PG8_LDA(At, 0, 0); PG8_STAGE(PG8_SA(1, 1), a1 + hstepA, voffA);
            PG8_WAIT_L(8); PG8_BAR; PG8_WAIT_L(0); PG8_MMA(0, 0, At, B0); PG8_BAR; PG8_SCHED;
            PG8_LDB(B1, 0, 1); PG8_STAGE(PG8_SB(0, 0), b2, voffB);
            PG8_BAR; PG8_WAIT_L(0); PG8_MMA(0, 1, At, B1); PG8_BAR;
            PG8_LDA(At, 0, 1); PG8_STAGE(PG8_SA(0, 0), a2, voffA);
            PG8_BAR; PG8_WAIT_L(0); PG8_MMA(1, 0, At, B0); PG8_BAR; PG8_SCHED;
            PG8_STAGE(PG8_SB(0, 1), b2 + hstepB, voffB);
            PG8_WAIT_V(6); PG8_BAR; PG8_MMA(1, 1, At, B1); PG8_BAR;
            PG8_LDB(B0, 1, 0); PG8_SCHED; PG8_LDA(At, 1, 0); PG8_STAGE(PG8_SA(0, 1), a2 + hstepA, voffA);
            PG8_WAIT_L(8); PG8_BAR; PG8_WAIT_L(0); PG8_MMA(0, 0, At, B0); PG8_BAR; PG8_SCHED;
            PG8_LDB(B1, 1, 1); PG8_STAGE(PG8_SB(1, 0), b3, voffB);
            PG8_BAR; PG8_WAIT_L(0); PG8_MMA(0, 1, At, B1); PG8_BAR;
            PG8_LDA(At, 1, 1); PG8_STAGE(PG8_SA(1, 0), a3, voffA);
            PG8_BAR; PG8_WAIT_L(0); PG8_MMA(1, 0, At, B0); PG8_BAR; PG8_SCHED;
            PG8_STAGE(PG8_SB(1, 1), b3 + hstepB, voffB);
            PG8_WAIT_V(6); PG8_BAR; PG8_MMA(1, 1, At, B1); PG8_BAR;
            }
        }
        if constexpr (ALIGN_EPI) { if (wr == 0) PG8_BAR; }
        if constexpr (!Epi::AFTER_DRAIN) { E(acc, cur, wr, wc, fr, fq); S.done(cur); }
        if (!has_next) break;
#pragma unroll
        for (int a = 0; a < 2; ++a)
#pragma unroll
            for (int b = 0; b < 2; ++b)
#pragma unroll
                for (int m = 0; m < 4; ++m)
#pragma unroll
                    for (int n = 0; n < 2; ++n) acc[a][b][m][n] = (f32x4){0.f, 0.f, 0.f, 0.f};
        cur = nxt; cA = nA; cB = nB; ++ui;
        if constexpr (ALIGN_EPI) { if (wr == 1) PG8_BAR; }
    }
    PG8_WAIT_V(0);
    if constexpr (!ALIGN_EPI) { if (wr == 0) PG8_BAR; }
    PG8_BAR;
    if constexpr (Epi::AFTER_DRAIN) { E.fused(acc, cur, wr, wc, fr, fq, lds, wid, lane); S.done(cur); }
#undef PG8_SA
#undef PG8_SB
#undef PG8_STAGE
#undef PG8_LDA
#undef PG8_LDB
#undef PG8_MMA
#undef PG8_WAIT_V
#undef PG8_WAIT_L
#undef PG8_BAR
#undef PG8_SCHED
}
}

constexpr int NWAVES = 8, NTHREADS = 512;
constexpr int M_TOK = 8192, SEQ = 4096, DM = 2048, NPROJ = 4096, AW = 1024, NH = 8, DFF = 8192, PLE = 256;
constexpr int SG = 64, SP = 64, SC = 16, CHL = 32, UGK = 640;
constexpr float RMS_EPS = 1e-6f;
constexpr float QSCALE = 0.08838834764831845f * 1.4426950408889634f;

constexpr size_t MiB = 1u << 20;
constexpr size_t WS_XN = 1 * MiB;
constexpr size_t WS_WIN = 33 * MiB, WS_WGLU = 49 * MiB, WS_WOUT = 51 * MiB;
constexpr size_t WS_Q = 59 * MiB, WS_K = 75 * MiB, WS_V = 91 * MiB;
constexpr size_t WS_SSMO = WS_K, WS_YB = WS_WIN;
constexpr size_t WS_UG = 107 * MiB, WS_E = 127 * MiB, WS_HST = 135 * MiB, WS_BSB = 151 * MiB;
constexpr size_t WS_OB = 191 * MiB, WS_LSE = 239 * MiB, WS_PW = 240 * MiB, WS_BBAR = 242 * MiB, WS_KT = 243 * MiB;
constexpr size_t WS_MIX = 123 * MiB;
constexpr size_t WS_WUP = 33 * MiB, WS_WDOWN = 65 * MiB, WS_WG = 97 * MiB, WS_WP = 105 * MiB, WS_PB = 106 * MiB;
constexpr size_t WS_HID = 123 * MiB;
constexpr size_t WS_FF = 1 * MiB;
constexpr size_t WS_XN3 = 123 * MiB, WS_GE = 155 * MiB;
constexpr size_t WS_END = 251 * MiB;
constexpr size_t OB_STRIDE = (size_t)M_TOK * AW;

constexpr int LDS_BYTES = 147456;
#define LAS __attribute__((address_space(3)))
typedef unsigned short bf16;
typedef unsigned v4u __attribute__((ext_vector_type(4)));
typedef unsigned v2u __attribute__((ext_vector_type(2)));
typedef float f32x4 __attribute__((ext_vector_type(4)));
typedef float f32x2 __attribute__((ext_vector_type(2)));
typedef float f32x16 __attribute__((ext_vector_type(16)));
typedef short bf16x8 __attribute__((ext_vector_type(8)));
using pg8::f2bf; using pg8::pk2; using pg8::bflo; using pg8::bfhi;
#define LDS_WAIT() asm volatile("s_waitcnt lgkmcnt(0)" ::: "memory")

__device__ __forceinline__ float wave_sum(float v) {
#pragma unroll
    for (int o = 1; o < 64; o <<= 1) v += __shfl_xor(v, o);
    return v;
}
__device__ __forceinline__ void transpose_item(const float* W, int K, int N, bf16* WT, LAS float* scr, int item, int lane) {
    const int nblk = N / 32, kb = item / nblk, nb = item % nblk, k0 = 64 * kb, n0 = 32 * nb;
    { f32x4 t4[8];
#pragma unroll
      for (int i = 0; i < 8; ++i) t4[i] = *(const f32x4*)(W + (size_t)(k0 + 8 * i + (lane >> 3)) * N + n0 + 4 * (lane & 7));
#pragma unroll
      for (int i = 0; i < 8; ++i) { LAS float* d = scr + (8 * i + (lane >> 3)) * 33 + 4 * (lane & 7); d[0] = t4[i].x; d[1] = t4[i].y; d[2] = t4[i].z; d[3] = t4[i].w; } }
    LDS_WAIT();
    const int c = lane & 7;
#pragma unroll
    for (int j = 0; j < 4; ++j) { const int n = (lane >> 3) + 8 * j; const LAS float* s = scr + (8 * c) * 33 + n;
        v4u o; o.x = pk2(s[0 * 33], s[1 * 33]); o.y = pk2(s[2 * 33], s[3 * 33]); o.z = pk2(s[4 * 33], s[5 * 33]); o.w = pk2(s[6 * 33], s[7 * 33]);
        *(v4u*)(WT + (size_t)(n0 + n) * K + k0 + 8 * c) = o; }
    LDS_WAIT();
}
__device__ __forceinline__ void rms_row_to_bf16(const float* xrow, const float* gain, bf16* orow, int lane) {
    const f32x4* xr = (const f32x4*)xrow + lane; const f32x4* gr = (const f32x4*)gain + lane;
    f32x4 v[8]; float s = 0.f;
#pragma unroll
    for (int j = 0; j < 8; ++j) { v[j] = xr[64 * j]; s += (v[j].x * v[j].x + v[j].y * v[j].y) + (v[j].z * v[j].z + v[j].w * v[j].w); }
    const float rs = 1.0f / sqrtf(wave_sum(s) * (1.0f / DM) + RMS_EPS);
    v2u* o8 = (v2u*)orow + lane;
#pragma unroll
    for (int j = 0; j < 8; ++j) { const f32x4 g = gr[64 * j]; v2u w; w.x = pk2(v[j].x * rs * g.x, v[j].y * rs * g.y); w.y = pk2(v[j].z * rs * g.z, v[j].w * rs * g.w); o8[64 * j] = w; }
}
template <bool WITH_XN>
__device__ __forceinline__ void residual_row(const bf16* yrow, const float* g1, const float* hbase, float* hout, const float* g2, bf16* xnrow, int lane) {
    float v[32]; float s = 0.f;
#pragma unroll
    for (int j = 0; j < 4; ++j) { const v4u w = *((const v4u*)yrow + lane + 64 * j);
        v[8 * j + 0] = bflo(w.x); v[8 * j + 1] = bfhi(w.x); v[8 * j + 2] = bflo(w.y); v[8 * j + 3] = bfhi(w.y); v[8 * j + 4] = bflo(w.z); v[8 * j + 5] = bfhi(w.z); v[8 * j + 6] = bflo(w.w); v[8 * j + 7] = bfhi(w.w); }
#pragma unroll
    for (int i = 0; i < 32; ++i) s += v[i] * v[i];
    const float rs = 1.0f / sqrtf(wave_sum(s) * (1.0f / DM) + RMS_EPS);
    float s2 = 0.f;
#pragma unroll
    for (int j = 0; j < 4; ++j) { const int e0 = (lane + 64 * j) * 8;
#pragma unroll
        for (int q = 0; q < 2; ++q) { const f32x4 g = *(const f32x4*)(g1 + e0 + 4 * q); const f32x4 b = *(const f32x4*)(hbase + e0 + 4 * q); f32x4 o;
            o.x = b.x + v[8 * j + 4 * q] * rs * g.x; o.y = b.y + v[8 * j + 4 * q + 1] * rs * g.y; o.z = b.z + v[8 * j + 4 * q + 2] * rs * g.z; o.w = b.w + v[8 * j + 4 * q + 3] * rs * g.w;
            *(f32x4*)(hout + e0 + 4 * q) = o; v[8 * j + 4 * q] = o.x; v[8 * j + 4 * q + 1] = o.y; v[8 * j + 4 * q + 2] = o.z; v[8 * j + 4 * q + 3] = o.w;
            s2 += (o.x * o.x + o.y * o.y) + (o.z * o.z + o.w * o.w); } }
    if (WITH_XN) {
        const float rs2 = 1.0f / sqrtf(wave_sum(s2) * (1.0f / DM) + RMS_EPS);
#pragma unroll
        for (int j = 0; j < 4; ++j) { const int e0 = (lane + 64 * j) * 8; const f32x4 ga = *(const f32x4*)(g2 + e0), gb = *(const f32x4*)(g2 + e0 + 4);
            *((v4u*)xnrow + lane + 64 * j) = (v4u){pk2(v[8 * j] * rs2 * ga.x, v[8 * j + 1] * rs2 * ga.y), pk2(v[8 * j + 2] * rs2 * ga.z, v[8 * j + 3] * rs2 * ga.w),
                                                    pk2(v[8 * j + 4] * rs2 * gb.x, v[8 * j + 5] * rs2 * gb.y), pk2(v[8 * j + 6] * rs2 * gb.z, v[8 * j + 7] * rs2 * gb.w)}; }
    }
}
__device__ __forceinline__ void cexp_lam(double lr, double li, double dt, double& ar, double& ai) {
    const double x = lr * dt;
    double e = 1.0; { double term = 1.0; for (int k = 1; k <= 14; ++k) { term *= x / (double)k; e += term; } }
    double th = li * dt;
    const double TWO_PI_HI = 6.283185307179586, TWO_PI_LO = 2.4492935982947064e-16;
    const double kq = rint(th * 0.15915494309189535); th = (th - kq * TWO_PI_HI) - kq * TWO_PI_LO;
    const double y = th * 0.0625, y2 = y * y;
    double s = y * (1.0 - y2 / 6.0 * (1.0 - y2 / 20.0 * (1.0 - y2 / 42.0 * (1.0 - y2 / 72.0 * (1.0 - y2 / 110.0 * (1.0 - y2 / 156.0))))));
    double c = 1.0 - y2 / 2.0 * (1.0 - y2 / 12.0 * (1.0 - y2 / 30.0 * (1.0 - y2 / 56.0 * (1.0 - y2 / 90.0 * (1.0 - y2 / 132.0)))));
#pragma unroll
    for (int k = 0; k < 4; ++k) { const double s2 = 2.0 * s * c, c2 = c * c - s * s; s = s2; c = c2; }
    ar = e * c; ai = e * s;
}
__device__ __forceinline__ double exp_f64(double x) {
    const double kq = rint(x * 1.4426950408889634); const double r = (x - kq * 0.6931471803691238) - kq * 1.9082149292705877e-10;
    double e = 1.0, term = 1.0; for (int k = 1; k <= 16; ++k) { term *= r / (double)k; e += term; }
    const long long bits = (long long)(1023 + (int)kq) << 52; return e * __builtin_bit_cast(double, bits);
}

__device__ __forceinline__ int crow(int reg, int h) { return (reg & 3) + 8 * (reg >> 2) + 4 * h; }
#define MFMA32(a, b, c) __builtin_amdgcn_mfma_f32_32x32x16_bf16((a), (b), (c), 0, 0, 0)
constexpr int VROW = 272;
__device__ __forceinline__ void attn_wave_unit(int wu, const bf16* Q, const bf16* K, const bf16* V, bf16* OB, float* LSE, LAS unsigned char* vbuf, int lane) {
    const int sub = wu & 3, blk = (wu >> 2) & 31, h = (wu >> 7) & 7, b = (wu >> 10) & 1, br = wu >> 11;
    const int dsh = 2 * br, d = 1 << dsh, nbm = (32 >> dsh) - 1, r = blk >> (5 - dsh), n = blk & nbm;
    const int iq = lane & 31, hh = lane >> 5;
    const int m0 = n * 128 + sub * 32;
    const size_t tokq = (size_t)b * SEQ + (size_t)(m0 + iq) * d + r;
    const int jmin = (n == 0) ? (4 - sub) : 0;
    const bf16* kbase = K + ((size_t)b * SEQ + r) * AW + h * 128 + hh * 8;
    const bf16* vbase = V + ((size_t)b * SEQ + r) * AW + h * 128 + (lane & 15) * 8;
    const size_t rstep = (size_t)d * AW;
    bf16x8 qf[8], kf[8]; v4u vst[8];
    { const bf16* qrow = Q + tokq * AW + h * 128 + hh * 8;
#pragma unroll
      for (int kk = 0; kk < 8; ++kk) qf[kk] = *(const bf16x8*)(qrow + kk * 16); }
    { const int kb = m0 - 128 + 32 * jmin; const bf16* krow = kbase + (size_t)(kb + iq) * rstep;
#pragma unroll
      for (int kk = 0; kk < 8; ++kk) kf[kk] = *(const bf16x8*)(krow + kk * 16);
#pragma unroll
      for (int it = 0; it < 8; ++it) vst[it] = *(const v4u*)(vbase + (size_t)(kb + it * 4 + (lane >> 4)) * rstep);
#pragma unroll
      for (int it = 0; it < 8; ++it) *(LAS v4u*)(vbuf + (it * 4 + (lane >> 4)) * VROW + (lane & 15) * 16) = vst[it]; }
    f32x16 o[4];
#pragma unroll
    for (int dt = 0; dt < 4; ++dt)
#pragma unroll
        for (int i = 0; i < 16; ++i) o[dt][i] = 0.f;
    float rmax = -1e30f, rsum = 0.f;
    for (int j = jmin; j <= 4; ++j) {
        LAS unsigned char* vcur = vbuf + ((j - jmin) & 1) * (32 * VROW);
        LAS unsigned char* vnxt = vbuf + (((j - jmin) & 1) ^ 1) * (32 * VROW);
        f32x16 st;
#pragma unroll
        for (int i = 0; i < 16; ++i) st[i] = 0.f;
#pragma unroll
        for (int kk = 0; kk < 8; ++kk) st = MFMA32(kf[kk], qf[kk], st);
        if (j < 4) {
            const int kb = m0 - 128 + 32 * (j + 1); const bf16* krow = kbase + (size_t)(kb + iq) * rstep;
#pragma unroll
            for (int kk = 0; kk < 8; ++kk) kf[kk] = *(const bf16x8*)(krow + kk * 16);
#pragma unroll
            for (int it = 0; it < 8; ++it) vst[it] = *(const v4u*)(vbase + (size_t)(kb + it * 4 + (lane >> 4)) * rstep);
        }
        if (j == 0) {
#pragma unroll
            for (int i = 0; i < 16; ++i) if (crow(i, hh) < iq) st[i] = -1e30f;
        }
        if (j == 4) {
#pragma unroll
            for (int i = 0; i < 16; ++i) if (crow(i, hh) > iq) st[i] = -1e30f;
        }
        float tmax = st[0];
#pragma unroll
        for (int i = 1; i < 16; ++i) tmax = fmaxf(tmax, st[i]);
        tmax = fmaxf(tmax, __shfl_xor(tmax, 32));
        const float nmax = fmaxf(rmax, tmax);
        const float alpha = __builtin_amdgcn_exp2f(rmax - nmax);
        rmax = nmax;
        float psum = 0.f;
#pragma unroll
        for (int i = 0; i < 16; ++i) { st[i] = __builtin_amdgcn_exp2f(st[i] - nmax); psum += st[i]; }
        rsum = rsum * alpha + psum;
#pragma unroll
        for (int dt = 0; dt < 4; ++dt)
#pragma unroll
            for (int i = 0; i < 16; ++i) o[dt][i] *= alpha;
        LDS_WAIT();
#pragma unroll
        for (int s = 0; s < 2; ++s) {
            bf16x8 pf;
#pragma unroll
            for (int e = 0; e < 8; ++e) pf[e] = (short)f2bf(st[8 * s + e]);
#pragma unroll
            for (int dt = 0; dt < 4; ++dt) {
                bf16x8 vf;
#pragma unroll
                for (int e = 0; e < 8; ++e) vf[e] = *(const LAS short*)(vcur + crow(8 * s + e, hh) * VROW + (dt * 32 + iq) * 2);
                o[dt] = MFMA32(vf, pf, o[dt]);
            }
        }
        if (j < 4) {
#pragma unroll
            for (int it = 0; it < 8; ++it) *(LAS v4u*)(vnxt + (it * 4 + (lane >> 4)) * VROW + (lane & 15) * 16) = vst[it];
        }
    }
    LDS_WAIT();
    const float tot = rsum + __shfl_xor(rsum, 32);
    const float inv = 1.0f / tot;
    bf16* orow = OB + (size_t)br * OB_STRIDE + tokq * AW + h * 128 + 4 * hh;
#pragma unroll
    for (int dt = 0; dt < 4; ++dt)
#pragma unroll
        for (int gq = 0; gq < 4; ++gq) { v2u w; w.x = pk2(o[dt][4 * gq] * inv, o[dt][4 * gq + 1] * inv); w.y = pk2(o[dt][4 * gq + 2] * inv, o[dt][4 * gq + 3] * inv);
            *(v2u*)(orow + dt * 32 + 8 * gq) = w; }
    if (hh == 0) LSE[((size_t)br * M_TOK + tokq) * NH + h] = rmax + __log2f(tot);
}

#define XB_TMO      128
#define XB_XCNT(j)  (256  + 64 * (j))
#define XB_XSUB(j)  (1280 + 64 * (j))
#define XB_XGEN(j)  (2304 + 64 * (j))
#define XB_TOP      3328
#define XB_TOPGEN   3392
#define XCD_BAR_WORDS 3456
#define XB_SPIN_CAP (1u << 18)

__device__ __forceinline__ unsigned xb_ld(unsigned* p)              { return __hip_atomic_load(p, __ATOMIC_RELAXED, __HIP_MEMORY_SCOPE_AGENT); }
__device__ __forceinline__ unsigned xb_add(unsigned* p, unsigned v) { return __hip_atomic_fetch_add(p, v, __ATOMIC_RELAXED, __HIP_MEMORY_SCOPE_AGENT); }
__device__ __forceinline__ unsigned xb_xcc_id() { return (unsigned)__builtin_amdgcn_s_getreg((3 << 11) | 20) & 0xFu; }
#define XB_SPIN(cond, bar) do { unsigned _sp = 0; while (cond) { __builtin_amdgcn_s_sleep(1); \
    if ((++_sp & 255u) == 0u) { if (xb_ld(&(bar)[XB_TMO])) break; if (_sp > XB_SPIN_CAP) { atomicAdd(&(bar)[XB_TMO], 1u); break; } } } } while (0)

struct XcdBarrier {
    unsigned* bar; unsigned x;
    volatile LAS unsigned* st;
};

__device__ __forceinline__ XcdBarrier xcd_barrier_post(unsigned* bar, volatile LAS unsigned* st) {
    XcdBarrier b; b.bar = bar; b.x = xb_xcc_id(); b.st = st;
    if (threadIdx.x == 0) (void)xb_add(&bar[XB_XCNT(b.x)], 1u);
    return b;
}
__device__ __forceinline__ void xcd_barrier_complete(unsigned* bar, unsigned x, unsigned& nloc, unsigned& nx) {
    const unsigned G = gridDim.x * gridDim.y * gridDim.z;
    unsigned sum, cnt, mine, sp = 0u;
    for (;;) {
        sum = 0u; cnt = 0u; mine = 0u;
#pragma unroll
        for (unsigned j = 0; j < 16; ++j) { const unsigned c = xb_ld(&bar[XB_XCNT(j)]); sum += c; cnt += (c > 0u) ? 1u : 0u; mine = (j == x) ? c : mine; }
        if (sum == G) break;
        __builtin_amdgcn_s_sleep(1);
        if ((++sp & 255u) == 0u) { if (xb_ld(&bar[XB_TMO])) break; if (sp > XB_SPIN_CAP) { atomicAdd(&bar[XB_TMO], 1u); break; } }
    }
    nloc = mine > 0u ? mine : 1u; nx = cnt > 0u ? cnt : 1u;
}

__device__ __forceinline__ void xcd_barrier(const XcdBarrier& b) {
    asm volatile("s_waitcnt vmcnt(0)" ::: "memory");
    __syncthreads();
    if (threadIdx.x == 0) {
        unsigned* bar = b.bar;
        __builtin_amdgcn_s_waitcnt(0);
        unsigned nloc = b.st[0], nx = b.st[1];
        if (nloc == 0u) { xcd_barrier_complete(bar, b.x, nloc, nx); b.st[0] = nloc; b.st[1] = nx; }
        const unsigned old = xb_add(&bar[XB_XSUB(b.x)], 1u);
        const unsigned gen = old / nloc;
        if (old + 1u == (gen + 1u) * nloc) {
            __builtin_amdgcn_fence(__ATOMIC_RELEASE, "agent");
            asm volatile("s_waitcnt vmcnt(0)" ::: "memory");
            const unsigned og = xb_add(&bar[XB_TOP], 1u);
            const unsigned tg = og / nx;
            if (og + 1u == (tg + 1u) * nx) xb_add(&bar[XB_TOPGEN], 1u);
            else XB_SPIN(xb_ld(&bar[XB_TOPGEN]) == tg, bar);
            __builtin_amdgcn_fence(__ATOMIC_ACQUIRE, "agent");
            xb_add(&bar[XB_XGEN(b.x)], 1u);
            asm volatile("s_waitcnt vmcnt(0)" ::: "memory");
        } else {
            XB_SPIN(xb_ld(&bar[XB_XGEN(b.x)]) == gen, bar);
            __builtin_amdgcn_fence(__ATOMIC_ACQUIRE, "agent");
            asm volatile("s_waitcnt vmcnt(0)" ::: "memory");
        }
    }
    __syncthreads();
}

struct Args {
    const float *x, *p, *mix_norm_pre, *w_in, *lam_re, *lam_im, *log_dt, *b_re, *b_im, *c_re, *c_im, *ssm_d, *w_glu, *b_glu, *attn_norm, *ssm_norm,
                *w_out, *mix_norm_post, *mlp_norm_pre, *w_up, *w_down, *mlp_norm_post, *ple_norm_pre, *w_g, *w_p, *ple_norm_post;
    float* out; unsigned char* ws; int ph_lo, ph_hi;
};
constexpr int N_PHASES = 13;
#ifndef REP_MASK
#define REP_MASK 0
#endif

__global__ void __launch_bounds__(NTHREADS, 2) fwd_megakernel(Args a) {
    extern __shared__ __attribute__((aligned(16))) unsigned char lds_raw[];
    LAS unsigned char* lds = (LAS unsigned char*)lds_raw;
    const int tid = threadIdx.x, lane = tid & 63, wave = __builtin_amdgcn_readfirstlane(tid >> 6);
    const int G = gridDim.x, bx = blockIdx.x;
    const int vcu = (G % 8 == 0) ? (bx % 8) * (G / 8) + bx / 8 : bx;
    const int gw = vcu * NWAVES + wave, NGW = G * NWAVES;
    const int gt = vcu * NTHREADS + tid, NGT = G * NTHREADS;
    unsigned char* ws = a.ws;
    bf16* XN = (bf16*)(ws + WS_XN);
    const int lo = a.ph_lo, hi = a.ph_hi;
#define IN(k) (lo <= (k) && (k) < hi)
    volatile LAS unsigned* MISC = (volatile LAS unsigned*)(lds + LDS_BYTES - 256);
    if (tid < 32) MISC[tid] = 0u;
    __syncthreads();
    if (lo < 0) cg::this_grid().sync();
    XcdBarrier bar = xcd_barrier_post((unsigned*)ws, MISC + 8);
#define GSYNC() xcd_barrier(bar)
#define SEAM(k) do { if (IN(k) && IN((k) + 1)) GSYNC(); } while (0)
#define PH_BEGIN(k) for (int rep_ = 0; rep_ < (IN(k) ? 1 + ((REP_MASK >> (k)) & 1) : 0); ++rep_) { if (rep_) GSYNC();
    LAS float* scr = (LAS float*)(lds + wave * 16384);

    PH_BEGIN(0)
        constexpr int I_IN = (DM / 64) * (NPROJ / 32), I_GLU = (AW / 64) * (AW / 32), I_OUT = (DM / 64) * (DM / 32);
        for (int it = gw; it < I_IN + I_GLU + I_OUT; it += NGW) {
            int r = it;
            if (r < I_IN) { transpose_item(a.w_in, DM, NPROJ, (bf16*)(ws + WS_WIN), scr, r, lane); continue; } r -= I_IN;
            if (r < I_GLU) { transpose_item(a.w_glu, AW, AW, (bf16*)(ws + WS_WGLU), scr, r, lane); continue; } r -= I_GLU;
            transpose_item(a.w_out, DM, DM, (bf16*)(ws + WS_WOUT), scr, r, lane);
        }
        for (int m = gw; m < M_TOK; m += NGW) rms_row_to_bf16(a.x + (size_t)m * DM, a.mix_norm_pre, XN + (size_t)m * DM, lane);
        for (int id = gt; id < SG * SP; id += NGT) {
            const int g = id >> 6;
            const double lr = (double)a.lam_re[id], li = (double)a.lam_im[id], dt = exp_f64((double)a.log_dt[g]);
            double ar, ai; cexp_lam(lr, li, dt, ar, ai);
            f32x2* pw = (f32x2*)(ws + WS_PW) + (size_t)id * 33;
            double pr = 1.0, pi = 0.0;
            for (int t = 0; t <= 32; ++t) { pw[t] = (f32x2){(float)pr, (float)pi}; const double nr = pr * ar - pi * ai, ni = pr * ai + pi * ar; pr = nr; pi = ni; }
            const double nr = ar - 1.0, ni = ai, den = lr * lr + li * li;
            const double cr = (nr * lr + ni * li) / den, ci = (ni * lr - nr * li) / den;
            f32x2* bb = (f32x2*)(ws + WS_BBAR) + (size_t)id * 16;
            for (int c = 0; c < SC; ++c) { const double br_ = (double)a.b_re[(size_t)id * 16 + c], bi_ = (double)a.b_im[(size_t)id * 16 + c];
                bb[c] = (f32x2){(float)(cr * br_ - ci * bi_), (float)(cr * bi_ + ci * br_)}; }
        }
    }
    SEAM(0);
    PH_BEGIN(1)
        { pg8::Gemm g{XN, (const bf16*)(ws + WS_WIN), M_TOK, NPROJ, DM, DM, DM}; pg8::StaticOrder S; S.init(M_TOK, NPROJ, G, bx);
          pg8::EpiProj E{(bf16*)(ws + WS_Q), (size_t)(WS_K - WS_Q) / 2, (bf16*)(ws + WS_UG), QSCALE};
          static_assert(WS_V - WS_K == WS_K - WS_Q, "q, k, v equally spaced");
          pg8::gemm_phase<pg8::EpiProj, pg8::StaticOrder, true, true>(lds, g, S, E); }
        const f32x2* PW = (const f32x2*)(ws + WS_PW); const f32x2* BB = (const f32x2*)(ws + WS_BBAR);
        for (int id = gt; id < SG * 256 * CHL; id += NGT) {
            const int tp = id & 31, q = (id >> 5) & 255, g = id >> 13;
            bf16* dst = (bf16*)(ws + WS_HST) + ((size_t)(g * 256 + q)) * 512 + tp * 16;
            v4u w0 = (v4u){0u, 0u, 0u, 0u}, w1 = w0;
            if (q < 128) { const int p = q & 63, part = q >> 6; const f32x2 pw = PW[(size_t)(g * 64 + p) * 33 + (31 - tp)]; const f32x2* bb = BB + (size_t)(g * 64 + p) * 16;
                float v[16];
#pragma unroll
                for (int c = 0; c < 16; ++c) { const f32x2 b_ = bb[c]; v[c] = part == 0 ? (b_.x * pw.x - b_.y * pw.y) : (b_.x * pw.y + b_.y * pw.x); }
                w0 = (v4u){pk2(v[0], v[1]), pk2(v[2], v[3]), pk2(v[4], v[5]), pk2(v[6], v[7])}; w1 = (v4u){pk2(v[8], v[9]), pk2(v[10], v[11]), pk2(v[12], v[13]), pk2(v[14], v[15])}; }
            *(v4u*)dst = w0; *(v4u*)(dst + 8) = w1;
        }
    }
    SEAM(1);
    PH_BEGIN(2)
        const int att0 = (G >= 128) ? SG : 0;
        if (bx < SG) {
            { pg8::Gemm g{(const bf16*)(ws + WS_UG), (const bf16*)(ws + WS_HST), SG * 256, SG * 256, 512, UGK, 512}; pg8::StateOrder S{SG, G, bx};
              pg8::EpiE E{(float*)(ws + WS_E)};
              pg8::gemm_phase<pg8::EpiE, pg8::StateOrder, true, true>(lds, g, S, E); }
            asm volatile("s_waitcnt vmcnt(0)" ::: "memory"); __syncthreads(); __builtin_amdgcn_fence(__ATOMIC_ACQUIRE, "agent");
            for (int g = bx; g < SG; g += G) {
                if (wave < 2) {
                    const int b = wave, p = lane;
                    const f32x2 a32 = ((const f32x2*)(ws + WS_PW))[(size_t)(g * 64 + p) * 33 + 32];
                    const float* E = (const float*)(ws + WS_E) + ((size_t)(g * 256 + b * 128)) * 128; bf16* ug = (bf16*)(ws + WS_UG) + ((size_t)(g * 256 + b * 128)) * UGK + 512;
                    float sr = 0.f, si = 0.f;
                    for (int c0 = 0; c0 < 128; c0 += 32) {
                        float er[32], ei[32];
#pragma unroll
                        for (int k = 0; k < 32; ++k) { er[k] = E[(size_t)(c0 + k) * 128 + p]; ei[k] = E[(size_t)(c0 + k) * 128 + 64 + p]; }
#pragma unroll
                        for (int k = 0; k < 32; ++k) {
                            ug[(size_t)(c0 + k) * UGK + p] = (bf16)f2bf(sr); ug[(size_t)(c0 + k) * UGK + 64 + p] = (bf16)f2bf(si);
                            const float nr = a32.x * sr - a32.y * si + er[k], ni = a32.x * si + a32.y * sr + ei[k]; sr = nr; si = ni; }
                    }
                }
            }
        }
        if (bx >= att0) {
            for (int wu = (bx - att0) * NWAVES + wave; wu < 3 * 2 * NH * 32 * 4; wu += (G - att0) * NWAVES)
                attn_wave_unit(wu, (const bf16*)(ws + WS_Q), (const bf16*)(ws + WS_K), (const bf16*)(ws + WS_V), (bf16*)(ws + WS_OB), (float*)(ws + WS_LSE), lds + wave * 17408, lane);
        }
        {
            const f32x2* PW = (const f32x2*)(ws + WS_PW); const f32x2* BB = (const f32x2*)(ws + WS_BBAR);
            for (int w = bx; w < SG * 4; w += G) {
                const int g = w >> 2, q = w & 3;
                LAS f32x2* Cs = (LAS f32x2*)lds; LAS f32x2* Bs = (LAS f32x2*)(lds + 8192); LAS f32x2* Ps = (LAS f32x2*)(lds + 16384); LAS float* KTs = (LAS float*)(lds + 20480);
                __syncthreads();
#pragma unroll
                for (int e = 0; e < 2; ++e) { const int i = tid + e * NTHREADS; Cs[i] = (f32x2){a.c_re[(size_t)g * 1024 + i], a.c_im[(size_t)g * 1024 + i]}; Bs[i] = BB[(size_t)g * 1024 + i]; }
                Ps[tid] = PW[(size_t)(g * 64 + (tid >> 3)) * 33 + 8 * q + (tid & 7)];
                __syncthreads();
                { const int cc = tid & 255, c = cc >> 4, cp = cc & 15, th = tid >> 8;
                  float acc[4] = {0.f, 0.f, 0.f, 0.f};
#pragma unroll 4
                  for (int p = 0; p < SP; ++p) { const f32x2 cv = Cs[c * 64 + p], bv = Bs[p * 16 + cp];
#pragma unroll
                      for (int k = 0; k < 4; ++k) { const f32x2 pw = Ps[p * 8 + 4 * th + k]; const float wr = cv.x * pw.x - cv.y * pw.y, wi = cv.x * pw.y + cv.y * pw.x; acc[k] += wr * bv.x - wi * bv.y; } }
#pragma unroll
                  for (int k = 0; k < 4; ++k) KTs[(4 * th + k) * 256 + cc] = acc[k]; }
                __syncthreads();
                {
#pragma unroll 4
                  for (int it = 0; it < 16; ++it) {
                      const int id = it * NTHREADS + tid, row = id >> 4, pi = id & 15, kb = pi >> 1, half = pi & 1, t = row >> 4, c = row & 15;
                      bf16* rowp = (bf16*)(ws + WS_BSB) + ((size_t)(g * 512 + row)) * UGK + half * 8;
                      const int k = 7 - kb, tp = t - (8 * q + k);
                      if (tp >= 0) { const LAS f32x4* kt = (const LAS f32x4*)(KTs + k * 256 + c * 16 + half * 8); const f32x4 k0 = kt[0], k1 = kt[1];
                          *(v4u*)(rowp + tp * 16) = (v4u){pk2(k0.x, k0.y), pk2(k0.z, k0.w), pk2(k1.x, k1.y), pk2(k1.z, k1.w)}; }
                      const int tz = t + 1 + 8 * q + kb;
                      if (tz < CHL) *(v4u*)(rowp + tz * 16) = (v4u){0u, 0u, 0u, 0u};
                  } }
            }
            for (int id = gt; id < SG * 512 * 8; id += NGT) {
                const int qb = id & 7, rest = id >> 3, c = rest & 15, t = (rest >> 4) & 31, g = rest >> 9;
                bf16* dst = (bf16*)(ws + WS_BSB) + ((size_t)(g * 512 + t * 16 + c)) * UGK + 512 + qb * 16;
                float v[16];
#pragma unroll
                for (int i = 0; i < 16; ++i) { const int comp = qb * 16 + i, part = comp >> 6, p = comp & 63; const f32x2 pw = PW[(size_t)(g * 64 + p) * 33 + t + 1];
                    const float cr = a.c_re[(size_t)(g * 16 + c) * 64 + p], ci = a.c_im[(size_t)(g * 16 + c) * 64 + p];
                    v[i] = part == 0 ? (cr * pw.x - ci * pw.y) : -(cr * pw.y + ci * pw.x); }
                *(v4u*)dst = (v4u){pk2(v[0], v[1]), pk2(v[2], v[3]), pk2(v[4], v[5]), pk2(v[6], v[7])};
                *(v4u*)(dst + 8) = (v4u){pk2(v[8], v[9]), pk2(v[10], v[11]), pk2(v[12], v[13]), pk2(v[14], v[15])};
            }
        }
    }
    SEAM(2);
    PH_BEGIN(3)
        { pg8::Gemm g{(const bf16*)(ws + WS_UG), (const bf16*)(ws + WS_BSB), SG * 256, SG * 512, UGK, UGK, UGK}; pg8::OutOrder S{SG, G, bx};
          pg8::EpiY E{(const bf16*)(ws + WS_UG), a.ssm_d, (bf16*)(ws + WS_YB)};
          pg8::gemm_phase<pg8::EpiY, pg8::OutOrder, true, true>(lds, g, S, E); }
        const int nglu = (M_TOK / 256) * (AW / 256);
        const int r0 = (G > nglu) ? nglu : 0;
        if (bx >= r0) {
            const bf16* OB = (const bf16*)(ws + WS_OB); const float* LSE = (const float*)(ws + WS_LSE);
            for (int m = (bx - r0) * NWAVES + wave; m < M_TOK; m += (G - r0) * NWAVES) {
                const int h = lane >> 3;
                const float l0 = LSE[((size_t)0 * M_TOK + m) * NH + h], l1 = LSE[((size_t)1 * M_TOK + m) * NH + h], l2 = LSE[((size_t)2 * M_TOK + m) * NH + h];
                const float mx = fmaxf(l0, fmaxf(l1, l2));
                float w0 = __builtin_amdgcn_exp2f(l0 - mx), w1 = __builtin_amdgcn_exp2f(l1 - mx), w2 = __builtin_amdgcn_exp2f(l2 - mx);
                const float wi = 1.0f / (w0 + w1 + w2); w0 *= wi; w1 *= wi; w2 *= wi;
                float v[16]; float s = 0.f;
#pragma unroll
                for (int hf = 0; hf < 2; ++hf) {
                    const size_t off = (size_t)m * AW + lane * 16 + hf * 8;
                    const v4u x0 = *(const v4u*)(OB + off), x1 = *(const v4u*)(OB + OB_STRIDE + off), x2 = *(const v4u*)(OB + 2 * OB_STRIDE + off);
                    v[hf * 8 + 0] = w0 * bflo(x0.x) + w1 * bflo(x1.x) + w2 * bflo(x2.x); v[hf * 8 + 1] = w0 * bfhi(x0.x) + w1 * bfhi(x1.x) + w2 * bfhi(x2.x);
                    v[hf * 8 + 2] = w0 * bflo(x0.y) + w1 * bflo(x1.y) + w2 * bflo(x2.y); v[hf * 8 + 3] = w0 * bfhi(x0.y) + w1 * bfhi(x1.y) + w2 * bfhi(x2.y);
                    v[hf * 8 + 4] = w0 * bflo(x0.z) + w1 * bflo(x1.z) + w2 * bflo(x2.z); v[hf * 8 + 5] = w0 * bfhi(x0.z) + w1 * bfhi(x1.z) + w2 * bfhi(x2.z);
                    v[hf * 8 + 6] = w0 * bflo(x0.w) + w1 * bflo(x1.w) + w2 * bflo(x2.w); v[hf * 8 + 7] = w0 * bfhi(x0.w) + w1 * bfhi(x1.w) + w2 * bfhi(x2.w);
                }
#pragma unroll
                for (int i = 0; i < 16; ++i) s += v[i] * v[i];
                const float rs = 1.0f / sqrtf(wave_sum(s) * (1.0f / AW) + RMS_EPS);
                bf16* xo = XN + (size_t)m * DM + lane * 16;
#pragma unroll
                for (int hf = 0; hf < 2; ++hf) { const f32x4 g0 = *(const f32x4*)(a.attn_norm + lane * 16 + hf * 8), g1 = *(const f32x4*)(a.attn_norm + lane * 16 + hf * 8 + 4);
                    *(v4u*)(xo + hf * 8) = (v4u){pk2(v[hf * 8] * rs * g0.x, v[hf * 8 + 1] * rs * g0.y), pk2(v[hf * 8 + 2] * rs * g0.z, v[hf * 8 + 3] * rs * g0.w),
                                                 pk2(v[hf * 8 + 4] * rs * g1.x, v[hf * 8 + 5] * rs * g1.y), pk2(v[hf * 8 + 6] * rs * g1.z, v[hf * 8 + 7] * rs * g1.w)}; }
            }
        }
    }
    SEAM(3);
    PH_BEGIN(4)
        { pg8::Gemm g{(const bf16*)(ws + WS_YB), (const bf16*)(ws + WS_WGLU), M_TOK, AW, AW, AW, AW}; pg8::StaticOrder S; S.init(M_TOK, AW, G, bx);
          pg8::EpiGLU E{(const bf16*)(ws + WS_YB), a.b_glu, (bf16*)(ws + WS_SSMO)};
          pg8::gemm_phase<pg8::EpiGLU, pg8::StaticOrder, true, true>(lds, g, S, E); }
        { const int nglu = (M_TOK / 256) * (AW / 256), r0 = (G > nglu) ? nglu : 0;
          if (bx >= r0) {
              constexpr int I_G = (DM / 64) * (DM / 32), I_P = (PLE / 64) * (DM / 32);
              for (int it = (bx - r0) * NWAVES + wave; it < I_G + I_P; it += (G - r0) * NWAVES) {
                  if (it < I_G) transpose_item(a.w_g, DM, DM, (bf16*)(ws + WS_WG), scr, it, lane);
                  else transpose_item(a.w_p, PLE, DM, (bf16*)(ws + WS_WP), scr, it - I_G, lane);
              }
              for (int id = (bx - r0) * NTHREADS + tid; id < M_TOK * PLE / 4; id += (G - r0) * NTHREADS) { const f32x4 v = ((const f32x4*)a.p)[id]; ((v2u*)(ws + WS_PB))[id] = (v2u){pk2(v.x, v.y), pk2(v.z, v.w)}; }
          } }
    }
    SEAM(4);
    PH_BEGIN(5)
        const bf16* SO = (const bf16*)(ws + WS_SSMO);
        for (int m = gw; m < M_TOK; m += NGW) {
            float v[16]; float s = 0.f;
#pragma unroll
            for (int hf = 0; hf < 2; ++hf) { const v4u x0 = *(const v4u*)(SO + (size_t)m * AW + lane * 16 + hf * 8);
                v[hf * 8 + 0] = bflo(x0.x); v[hf * 8 + 1] = bfhi(x0.x); v[hf * 8 + 2] = bflo(x0.y); v[hf * 8 + 3] = bfhi(x0.y);
                v[hf * 8 + 4] = bflo(x0.z); v[hf * 8 + 5] = bfhi(x0.z); v[hf * 8 + 6] = bflo(x0.w); v[hf * 8 + 7] = bfhi(x0.w); }
#pragma unroll
            for (int i = 0; i < 16; ++i) s += v[i] * v[i];
            const float rs = 1.0f / sqrtf(wave_sum(s) * (1.0f / AW) + RMS_EPS);
            bf16* xo = XN + (size_t)m * DM + AW + lane * 16;
#pragma unroll
            for (int hf = 0; hf < 2; ++hf) { const f32x4 g0 = *(const f32x4*)(a.ssm_norm + lane * 16 + hf * 8), g1 = *(const f32x4*)(a.ssm_norm + lane * 16 + hf * 8 + 4);
                *(v4u*)(xo + hf * 8) = (v4u){pk2(v[hf * 8] * rs * g0.x, v[hf * 8 + 1] * rs * g0.y), pk2(v[hf * 8 + 2] * rs * g0.z, v[hf * 8 + 3] * rs * g0.w),
                                             pk2(v[hf * 8 + 4] * rs * g1.x, v[hf * 8 + 5] * rs * g1.y), pk2(v[hf * 8 + 6] * rs * g1.z, v[hf * 8 + 7] * rs * g1.w)}; }
        }
    }
    SEAM(5);
    PH_BEGIN(6)
        pg8::Gemm g{XN, (const bf16*)(ws + WS_WOUT), M_TOK, DM, DM, DM, DM}; pg8::StaticOrder S; S.init(M_TOK, DM, G, bx);
        pg8::EpiBf16Plain E{(bf16*)(ws + WS_MIX), DM};
        pg8::gemm_phase<pg8::EpiBf16Plain, pg8::StaticOrder, true, true>(lds, g, S, E);
    }
    SEAM(6);
    PH_BEGIN(7)
        for (int m = gw; m < M_TOK; m += NGW)
            residual_row<true>((const bf16*)(ws + WS_MIX) + (size_t)m * DM, a.mix_norm_post, a.x + (size_t)m * DM, a.out + (size_t)m * DM, a.mlp_norm_pre, XN + (size_t)m * DM, lane);
        constexpr int I_UP = (DM / 64) * (DFF / 32), I_DOWN = (DFF / 64) * (DM / 32);
        for (int it = gw; it < I_UP + I_DOWN; it += NGW) {
            int r = it;
            if (r < I_UP) { transpose_item(a.w_up, DM, DFF, (bf16*)(ws + WS_WUP), scr, r, lane); continue; } r -= I_UP;
            transpose_item(a.w_down, DFF, DM, (bf16*)(ws + WS_WDOWN), scr, r, lane);
        }
    }
    SEAM(7);
    PH_BEGIN(8)
        pg8::Gemm g{XN, (const bf16*)(ws + WS_WUP), M_TOK, DFF, DM, DM, DM}; pg8::StaticOrder S; S.init(M_TOK, DFF, G, bx);
        pg8::EpiRelu2 E{(bf16*)(ws + WS_HID), DFF};
        pg8::gemm_phase<pg8::EpiRelu2, pg8::StaticOrder, true, true>(lds, g, S, E);
    }
    SEAM(8);
    PH_BEGIN(9)
        pg8::Gemm g{(const bf16*)(ws + WS_HID), (const bf16*)(ws + WS_WDOWN), M_TOK, DM, DFF, DFF, DFF}; pg8::StaticOrder S; S.init(M_TOK, DM, G, bx);
        pg8::EpiBf16Plain E{(bf16*)(ws + WS_FF), DM};
        pg8::gemm_phase<pg8::EpiBf16Plain, pg8::StaticOrder, true, true>(lds, g, S, E);
    }
    SEAM(9);
    PH_BEGIN(10)
        { pg8::Gemm g{(const bf16*)(ws + WS_PB), (const bf16*)(ws + WS_WP), M_TOK, DM, PLE, PLE, PLE}; pg8::StaticOrder S; S.init(M_TOK, DM, G, bx);
          pg8::EpiBf16Plain E{(bf16*)(ws + WS_GE), DM};
          pg8::gemm_phase<pg8::EpiBf16Plain, pg8::StaticOrder, true, true>(lds, g, S, E); }
        for (int m = gw; m < M_TOK; m += NGW)
            residual_row<true>((const bf16*)(ws + WS_FF) + (size_t)m * DM, a.mlp_norm_post, a.out + (size_t)m * DM, a.out + (size_t)m * DM, a.ple_norm_pre, (bf16*)(ws + WS_XN3) + (size_t)m * DM, lane);
    }
    SEAM(10);
    PH_BEGIN(11)
        pg8::Gemm g{(const bf16*)(ws + WS_XN3), (const bf16*)(ws + WS_WG), M_TOK, DM, DM, DM, DM}; pg8::StaticOrder S; S.init(M_TOK, DM, G, bx);
        pg8::EpiGateBf E{(bf16*)(ws + WS_GE), DM};
        pg8::gemm_phase<pg8::EpiGateBf, pg8::StaticOrder, true, true>(lds, g, S, E);
    }
    SEAM(11);
    PH_BEGIN(12)
        for (int m = gw; m < M_TOK; m += NGW)
            residual_row<false>((const bf16*)(ws + WS_GE) + (size_t)m * DM, a.ple_norm_post, a.out + (size_t)m * DM, a.out + (size_t)m * DM, nullptr, nullptr, lane);
    }
#undef IN
#undef SEAM
}

#ifndef MK_PER_PHASE
#define MK_PER_PHASE 0
#endif
extern "C" void kernel_launch(void* const* d_in, const int* in_sizes, int n_in, void* d_out, int out_size, void* d_ws, size_t ws_size, hipStream_t stream) {
    static int grid = 0;
    if (grid == 0) {
        if (n_in != 26 || in_sizes[0] != M_TOK * DM || out_size != M_TOK * DM || ws_size < WS_END) { fprintf(stderr, "kernel_launch: unexpected shapes / workspace (n_in %d, ws %zu)\n", n_in, ws_size); grid = -1; return; }
        int dev = 0, cus = 0, per_cu = 0;
        if (hipGetDevice(&dev) != hipSuccess || hipDeviceGetAttribute(&cus, hipDeviceAttributeMultiprocessorCount, dev) != hipSuccess) { grid = -1; return; }
        if (hipFuncSetAttribute((const void*)fwd_megakernel, hipFuncAttributeMaxDynamicSharedMemorySize, LDS_BYTES) != hipSuccess) { fprintf(stderr, "kernel_launch: hipFuncSetAttribute failed\n"); grid = -1; return; }
        if (hipOccupancyMaxActiveBlocksPerMultiprocessor(&per_cu, (const void*)fwd_megakernel, NTHREADS, LDS_BYTES) != hipSuccess || per_cu < 1) { fprintf(stderr, "kernel_launch: occupancy query says %d blocks per CU\n", per_cu); (void)hipGetLastError(); grid = -1; return; }
        grid = cus;
    }
    if (grid < 0) return;
    Args a{};
    const float** ap = (const float**)&a;
    for (int i = 0; i < 26; ++i) ap[i] = (const float*)d_in[i];
    a.out = (float*)d_out; a.ws = (unsigned char*)d_ws;
#if MK_PER_PHASE
    for (int ph = 0; ph < N_PHASES; ++ph) { a.ph_lo = ph; a.ph_hi = ph + 1; hipLaunchKernelGGL(fwd_megakernel, dim3(grid), dim3(NTHREADS), LDS_BYTES, stream, a); }
#else
    if (hipMemsetAsync(d_ws, 0, 65536, stream) != hipSuccess) { fprintf(stderr, "kernel_launch: memset failed\n"); return; }
    a.ph_lo = 0; a.ph_hi = N_PHASES;
    void* kargs[] = {&a};
    hipError_t e = hipLaunchCooperativeKernel((const void*)fwd_megakernel, dim3(grid), dim3(NTHREADS), kargs, LDS_BYTES, stream);
    if (e != hipSuccess) fprintf(stderr, "kernel_launch: cooperative launch failed: %s (grid %d)\n", hipGetErrorString(e), grid);
#endif
}
```
